# Optimizing an MI355X kernel written in HIP

```python
import math
import jax, jax.numpy as jnp
from jax import lax
import numpy as np


D_MODEL = 1024
BATCH = 32
SEQ = 256
DEPTH = 4
DEC_BATCH = 2
DEC_SEQ = 4096
PAST_LEN = 256

GRID_W = 64
N_MIXERS = 4
N_MLA = (DEPTH + 3) // 4
N_DIFF = (DEPTH + 2) // 4
N_GQA = (DEPTH + 1) // 4
N_LRU = DEPTH // 4
EPS = 1e-6
ROPE_THETA = 10000.0
Q_BLOCK = 128
FFN_HIDDEN = -(-8 * D_MODEL // (3 * 256)) * 256
MLA_HEADS = 8
MLA_NOPE = 128
MLA_ROPE = 64
MLA_V = 128
MLA_Q_RANK = 384
MLA_KV_RANK = 256
DIFF_HD = 64
DIFF_HEADS = D_MODEL // (2 * DIFF_HD)
GQA_HD = 128
GQA_Q_HEADS = D_MODEL // GQA_HD
GQA_KV_HEADS = 2
D_RNN = D_MODEL
LRU_BLOCKS = 8
LRU_BLK = D_RNN // LRU_BLOCKS
CONV_W = 4
CONV_LEFT = 1
LRU_C = 8.0

kernel_name = "hybrid_diffusion_mla_diff_gqa_rglru_step"


def rmsnorm(x, g):
    xf = x.astype(jnp.float32)
    y = xf * lax.rsqrt(jnp.mean(xf * xf, axis=-1, keepdims=True) + EPS)
    return (y * g.astype(jnp.float32)).astype(x.dtype)


def axial_rope(n_tok, rot_dim):
    rows = n_tok // GRID_W
    row = jnp.repeat(jnp.arange(rows), GRID_W).astype(jnp.float32)
    col = jnp.tile(jnp.arange(GRID_W), rows).astype(jnp.float32)
    n_freq = rot_dim // 4
    inv = ROPE_THETA ** (-jnp.arange(n_freq, dtype=jnp.float32) / n_freq)
    ang = jnp.concatenate([row[:, None] * inv, col[:, None] * inv], axis=-1)
    return jnp.cos(ang), jnp.sin(ang)


def apply_rope(x, cos, sin):
    half = x.shape[-1] // 2
    shape = (1, x.shape[1]) + (1,) * (x.ndim - 3) + (half,)
    cos, sin = cos.reshape(shape), sin.reshape(shape)
    xf = x.astype(jnp.float32)
    x1, x2 = xf[..., :half], xf[..., half:]
    return jnp.concatenate([x1 * cos - x2 * sin, x1 * sin + x2 * cos], axis=-1).astype(x.dtype)


def blocked_attention(q, k, v):
    b, s, hq, dq = q.shape
    hkv, dv = k.shape[2], v.shape[-1]
    g = hq // hkv
    nb = s // Q_BLOCK
    scale = dq ** -0.5
    qb = jnp.moveaxis(q.reshape(b, nb, Q_BLOCK, hkv, g, dq), 1, 0)

    def attend(qblk):
        sc = jnp.einsum('bqhgd,bkhd->bhgqk', qblk, k).astype(jnp.float32) * scale
        p = jax.nn.softmax(sc, axis=-1).astype(v.dtype)
        return jnp.einsum('bhgqk,bkhd->bqhgd', p, v)

    o = lax.map(attend, qb)
    return jnp.moveaxis(o, 0, 1).reshape(b, s, hq, dv)


def mla_mixer(h, w_in, g_cq, g_ckv, w_uq, w_ukv, g_qk, w_o, ctx):
    b, s, _ = h.shape
    proj = h @ w_in
    cq = rmsnorm(proj[..., :MLA_Q_RANK], g_cq)
    ckv = rmsnorm(proj[..., MLA_Q_RANK:MLA_Q_RANK + MLA_KV_RANK], g_ckv)
    kr = rmsnorm(proj[..., MLA_Q_RANK + MLA_KV_RANK:], g_qk[1, MLA_NOPE:])
    q = (cq @ w_uq).reshape(b, s, MLA_HEADS, MLA_NOPE + MLA_ROPE)
    q_nope = rmsnorm(q[..., :MLA_NOPE], g_qk[0, :MLA_NOPE])
    q_rope = rmsnorm(q[..., MLA_NOPE:], g_qk[0, MLA_NOPE:])
    keys_ckv, keys_kr = ckv, kr
    if ctx is not None:
        cos, sin = axial_rope(s, MLA_ROPE)
        q_rope = apply_rope(q_rope, cos, sin)
        keys_ckv = jnp.concatenate([ctx[0], ckv], axis=1)
        keys_kr = jnp.concatenate([ctx[1], apply_rope(kr, cos, sin)], axis=1)
    l = keys_ckv.shape[1]
    kv = (keys_ckv @ w_ukv).reshape(b, l, MLA_HEADS, MLA_NOPE + MLA_V)
    k_nope = rmsnorm(kv[..., :MLA_NOPE], g_qk[1, :MLA_NOPE])
    k = jnp.concatenate([k_nope, jnp.broadcast_to(keys_kr[:, :, None, :], (b, l, MLA_HEADS, MLA_ROPE))], axis=-1)
    o = blocked_attention(jnp.concatenate([q_nope, q_rope], axis=-1), k, kv[..., MLA_NOPE:])
    return o.reshape(b, s, MLA_HEADS * MLA_V) @ w_o, (ckv, kr)


def diff_mixer(h, w_in, g_qk, lam, g_sub, w_o, lambda_init, ctx):
    b, s, _ = h.shape
    q, k, v = jnp.split(h @ w_in, 3, axis=-1)
    q = rmsnorm(q.reshape(b, s, DIFF_HEADS, 2, DIFF_HD), g_qk[0])
    k = rmsnorm(k.reshape(b, s, DIFF_HEADS, 2, DIFF_HD), g_qk[1])
    v = v.reshape(b, s, DIFF_HEADS, 2 * DIFF_HD)
    keys, vals = k, v
    if ctx is not None:
        cos, sin = axial_rope(s, DIFF_HD)
        q = apply_rope(q, cos, sin)
        keys = jnp.concatenate([ctx[0], apply_rope(k, cos, sin)], axis=1)
        vals = jnp.concatenate([ctx[1], v], axis=1)
    lam = lam.astype(jnp.float32)
    lam_full = jnp.exp(jnp.sum(lam[0] * lam[1])) - jnp.exp(jnp.sum(lam[2] * lam[3])) + lambda_init
    o1 = blocked_attention(q[:, :, :, 0], keys[:, :, :, 0], vals)
    o2 = blocked_attention(q[:, :, :, 1], keys[:, :, :, 1], vals)
    o = o1.astype(jnp.float32) - lam_full * o2.astype(jnp.float32)
    o = (rmsnorm(o, g_sub) * (1.0 - lambda_init)).astype(h.dtype)
    return o.reshape(b, s, DIFF_HEADS * 2 * DIFF_HD) @ w_o, (k, v)


def gqa_mixer(h, w_in, g_qk, w_o, ctx):
    b, s, _ = h.shape
    nq, nk = GQA_Q_HEADS * GQA_HD, GQA_KV_HEADS * GQA_HD
    proj = h @ w_in
    q = rmsnorm(proj[..., :nq].reshape(b, s, GQA_Q_HEADS, GQA_HD), g_qk[0])
    k = rmsnorm(proj[..., nq:nq + nk].reshape(b, s, GQA_KV_HEADS, GQA_HD), g_qk[1])
    v = proj[..., nq + nk:].reshape(b, s, GQA_KV_HEADS, GQA_HD)
    keys, vals = k, v
    if ctx is not None:
        cos, sin = axial_rope(s, GQA_HD)
        q = apply_rope(q, cos, sin)
        keys = jnp.concatenate([ctx[0], apply_rope(k, cos, sin)], axis=1)
        vals = jnp.concatenate([ctx[1], v], axis=1)
    o = blocked_attention(q, keys, vals)
    return o.reshape(b, s, nq) @ w_o, (k, v)


def centred_conv(x, w, bias):
    s = x.shape[1]
    xp = jnp.pad(x, ((0, 0), (CONV_LEFT, CONV_W - 1 - CONV_LEFT), (0, 0)))
    y = xp[:, 0:s] * w[0]
    for t in range(1, CONV_W):
        y = y + xp[:, t:t + s] * w[t]
    return y + bias


def _linear_combine(e1, e2):
    a1, b1 = e1
    a2, b2 = e2
    return a1 * a2, a2 * b1 + b2


def rglru_scan(x, w_gate, b_gate, lam, h0):
    b, s, _ = x.shape
    xb = x.reshape(b, s, LRU_BLOCKS, LRU_BLK)
    g = jnp.einsum('bsnk,gnkj->gbsnj', xb, w_gate).reshape(2, b, s, D_RNN)
    g = g.astype(jnp.float32) + b_gate.astype(jnp.float32)[:, None, None, :]
    r, i = jax.nn.sigmoid(g[0]), jax.nn.sigmoid(g[1])
    log_a = -LRU_C * r * jax.nn.softplus(-lam.astype(jnp.float32))
    a = jnp.exp(log_a)
    u = jnp.sqrt(-jnp.expm1(2.0 * log_a)) * (i * x.astype(jnp.float32))
    if h0 is not None:
        u = u.at[:, 0].add(a[:, 0] * h0)
    _, hs = lax.associative_scan(_linear_combine, (a, u), axis=1)
    return hs


def lru_mixer(h, w_in, conv_w, conv_b, w_gate, b_gate, lam, w_out, ctx):
    gate_branch, xr = jnp.split(h @ w_in, 2, axis=-1)
    xr = centred_conv(xr, conv_w, conv_b)
    h0f = None if ctx is None else ctx[0][:, 0].astype(jnp.float32)
    h0b = None if ctx is None else ctx[0][:, 1].astype(jnp.float32)
    hf = rglru_scan(xr, w_gate[0], b_gate[0], lam[0], h0f)
    hb = jnp.flip(rglru_scan(jnp.flip(xr, axis=1), w_gate[1], b_gate[1], lam[1], h0b), axis=1)
    y = (hf + hb).astype(h.dtype) * jax.nn.gelu(gate_branch)
    state = jnp.stack([hf[:, -1], hb[:, 0]], axis=1)
    return y @ w_out, (state,)


def swiglu(h, w_in, w_out):
    gte, up = jnp.split(h @ w_in, 2, axis=-1)
    return (jax.nn.silu(gte) * up) @ w_out


def setup_inputs(seed: int = 0) -> dict:
    key = jax.random.key(seed)
    ks = iter(jax.random.split(key, 48))
    D = D_MODEL

    def nrm(shape, scale=1.0):
        return jax.random.normal(next(ks), shape, jnp.float32) * scale

    def gain(shape):
        return 1.0 + nrm(shape, 0.02)

    u = jax.random.uniform(next(ks), (N_LRU, 2, D_RNN), jnp.float32, 0.9, 0.999)
    a0 = u ** (1.0 / LRU_C)
    lru_lambda = jnp.log(a0 / (1.0 - a0))
    return {
        "x_prompt": nrm((BATCH, SEQ, D)),
        "x_sample": nrm((DEC_BATCH, DEC_SEQ, D)),
        "cache_mla_ckv": nrm((DEC_BATCH, N_MLA, PAST_LEN, MLA_KV_RANK)),
        "cache_mla_krope": nrm((DEC_BATCH, N_MLA, PAST_LEN, MLA_ROPE)),
        "cache_diff_k": nrm((DEC_BATCH, N_DIFF, PAST_LEN, DIFF_HEADS, 2, DIFF_HD)),
        "cache_diff_v": nrm((DEC_BATCH, N_DIFF, PAST_LEN, DIFF_HEADS, 2 * DIFF_HD)),
        "cache_gqa_k": nrm((DEC_BATCH, N_GQA, PAST_LEN, GQA_KV_HEADS, GQA_HD)),
        "cache_gqa_v": nrm((DEC_BATCH, N_GQA, PAST_LEN, GQA_KV_HEADS, GQA_HD)),
        "state_lru_h": nrm((DEC_BATCH, N_LRU, 2, D_RNN), 0.5),
        "c": nrm((DEC_BATCH, D)),
        "c_ctx": nrm((D,)),
        "w_mod": nrm((DEPTH, D, 6 * D), 0.5 * D ** -0.5),
        "b_mod": nrm((DEPTH, 6 * D), 0.01),
        "g_norm1": gain((DEPTH, D)),
        "g_norm2": gain((DEPTH, D)),
        "w_ffn_in": nrm((DEPTH, D, 2 * FFN_HIDDEN), D ** -0.5),
        "w_ffn_out": nrm((DEPTH, FFN_HIDDEN, D), FFN_HIDDEN ** -0.5),
        "mla_w_in": nrm((N_MLA, D, MLA_Q_RANK + MLA_KV_RANK + MLA_ROPE), D ** -0.5),
        "mla_g_cq": gain((N_MLA, MLA_Q_RANK)),
        "mla_g_ckv": gain((N_MLA, MLA_KV_RANK)),
        "mla_w_uq": nrm((N_MLA, MLA_Q_RANK, MLA_HEADS * (MLA_NOPE + MLA_ROPE)), MLA_Q_RANK ** -0.5),
        "mla_w_ukv": nrm((N_MLA, MLA_KV_RANK, MLA_HEADS * (MLA_NOPE + MLA_V)), MLA_KV_RANK ** -0.5),
        "mla_g_qk": gain((N_MLA, 2, MLA_NOPE + MLA_ROPE)),
        "mla_w_o": nrm((N_MLA, MLA_HEADS * MLA_V, D), (MLA_HEADS * MLA_V) ** -0.5),
        "diff_w_in": nrm((N_DIFF, D, 3 * DIFF_HEADS * 2 * DIFF_HD), D ** -0.5),
        "diff_g_qk": gain((N_DIFF, 2, DIFF_HD)),
        "diff_lambda": nrm((N_DIFF, 4, DIFF_HD), 0.1),
        "diff_g_sub": gain((N_DIFF, 2 * DIFF_HD)),
        "diff_w_o": nrm((N_DIFF, DIFF_HEADS * 2 * DIFF_HD, D), (DIFF_HEADS * 2 * DIFF_HD) ** -0.5),
        "gqa_w_in": nrm((N_GQA, D, (GQA_Q_HEADS + 2 * GQA_KV_HEADS) * GQA_HD), D ** -0.5),
        "gqa_g_qk": gain((N_GQA, 2, GQA_HD)),
        "gqa_w_o": nrm((N_GQA, GQA_Q_HEADS * GQA_HD, D), (GQA_Q_HEADS * GQA_HD) ** -0.5),
        "lru_w_in": nrm((N_LRU, D, 2 * D_RNN), D ** -0.5),
        "lru_conv_w": nrm((N_LRU, CONV_W, D_RNN), CONV_W ** -0.5),
        "lru_conv_b": nrm((N_LRU, D_RNN), 0.01),
        "lru_w_gate": nrm((N_LRU, 2, 2, LRU_BLOCKS, LRU_BLK, LRU_BLK), LRU_BLK ** -0.5),
        "lru_b_gate": nrm((N_LRU, 2, 2, D_RNN), 0.01),
        "lru_lambda": lru_lambda,
        "lru_w_out": nrm((N_LRU, D_RNN, D), D_RNN ** -0.5),
    }


def reference(x_prompt, x_sample, cache_mla_ckv, cache_mla_krope, cache_diff_k, cache_diff_v,
              cache_gqa_k, cache_gqa_v, state_lru_h, c, c_ctx, w_mod, b_mod, g_norm1, g_norm2,
              w_ffn_in, w_ffn_out, mla_w_in, mla_g_cq, mla_g_ckv, mla_w_uq, mla_w_ukv, mla_g_qk,
              mla_w_o, diff_w_in, diff_g_qk, diff_lambda, diff_g_sub, diff_w_o, gqa_w_in, gqa_g_qk,
              gqa_w_o, lru_w_in, lru_conv_w, lru_conv_b, lru_w_gate, lru_b_gate, lru_lambda, lru_w_out):

    def token_mixer(l, h, ctx):
        kind, j = l % N_MIXERS, l // N_MIXERS
        if kind == 0:
            return mla_mixer(h, mla_w_in[j], mla_g_cq[j], mla_g_ckv[j], mla_w_uq[j], mla_w_ukv[j],
                             mla_g_qk[j], mla_w_o[j], ctx)
        if kind == 1:
            lambda_init = 0.8 - 0.6 * math.exp(-0.3 * l)
            return diff_mixer(h, diff_w_in[j], diff_g_qk[j], diff_lambda[j], diff_g_sub[j], diff_w_o[j],
                              lambda_init, ctx)
        if kind == 2:
            return gqa_mixer(h, gqa_w_in[j], gqa_g_qk[j], gqa_w_o[j], ctx)
        return lru_mixer(h, lru_w_in[j], lru_conv_w[j], lru_conv_b[j], lru_w_gate[j], lru_b_gate[j],
                         lru_lambda[j], lru_w_out[j], ctx)

    def layer_cache(l):
        kind, j = l % N_MIXERS, l // N_MIXERS
        if kind == 0:
            return (cache_mla_ckv[:, j], cache_mla_krope[:, j])
        if kind == 1:
            return (cache_diff_k[:, j], cache_diff_v[:, j])
        if kind == 2:
            return (cache_gqa_k[:, j], cache_gqa_v[:, j])
        return (state_lru_h[:, j],)

    def trunk_layer(l, x, cond, ctx):
        mod = (jax.nn.silu(cond) @ w_mod[l] + b_mod[l]).reshape(cond.shape[0], 6, D_MODEL)[:, :, None, :]
        h = rmsnorm(x, g_norm1[l]) * (1.0 + mod[:, 1]) + mod[:, 0]
        out, ctx_tensors = token_mixer(l, h, ctx)
        x = x + mod[:, 2] * out
        h = rmsnorm(x, g_norm2[l]) * (1.0 + mod[:, 4]) + mod[:, 3]
        x = x + mod[:, 5] * swiglu(h, w_ffn_in[l], w_ffn_out[l])
        return x, ctx_tensors

    x = x_prompt
    ctx_states = []
    for l in range(DEPTH):
        x, st = trunk_layer(l, x, c_ctx[None, :], None)
        ctx_states.append(st)
    y_prompt = x

    def collect(kind, idx):
        return jnp.stack([ctx_states[l][idx] for l in range(kind, DEPTH, N_MIXERS)], axis=1)

    new_mla_ckv = collect(0, 0)
    new_mla_krope = collect(0, 1)
    new_diff_k = collect(1, 0)
    new_diff_v = collect(1, 1)
    new_gqa_k = collect(2, 0)
    new_gqa_v = collect(2, 1)
    new_lru_h = collect(3, 0)

    x = x_sample
    for l in range(DEPTH):
        x, _ = trunk_layer(l, x, c, layer_cache(l))
    y_sample = x

    return (y_prompt, y_sample, new_mla_ckv, new_mla_krope, new_diff_k, new_diff_v, new_gqa_k, new_gqa_v, new_lru_h)
```

```cpp
#include <hip/hip_runtime.h>
#include <hip/hip_cooperative_groups.h>
#include <cstdio>
namespace cg = cooperative_groups;

typedef unsigned short u16;
typedef unsigned int u32;
using bf16x8 = __attribute__((ext_vector_type(8))) short;
using f32x16 = __attribute__((ext_vector_type(16))) float;
typedef __bf16 v2bf __attribute__((ext_vector_type(2)));
typedef float v2f __attribute__((ext_vector_type(2)));
typedef unsigned int u32x4 __attribute__((ext_vector_type(4)));
typedef float f32x4v __attribute__((ext_vector_type(4)));
#define GAS __attribute__((address_space(1)))
typedef const float GAS* GF;
#define DI __device__ __forceinline__

enum {
  I_XP, I_XS, I_CMLA_CKV, I_CMLA_KR, I_CDIFF_K, I_CDIFF_V, I_CGQA_K, I_CGQA_V, I_ST_LRU, I_C, I_CCTX,
  I_WMOD, I_BMOD, I_GN1, I_GN2, I_WFFN_IN, I_WFFN_OUT,
  I_MLA_WIN, I_MLA_GCQ, I_MLA_GCKV, I_MLA_WUQ, I_MLA_WUKV, I_MLA_GQK, I_MLA_WO,
  I_DIFF_WIN, I_DIFF_GQK, I_DIFF_LAM, I_DIFF_GSUB, I_DIFF_WO,
  I_GQA_WIN, I_GQA_GQK, I_GQA_WO,
  I_LRU_WIN, I_LRU_CONVW, I_LRU_CONVB, I_LRU_WGATE, I_LRU_BGATE, I_LRU_LAM, I_LRU_WOUT, N_IN
};

struct KArgs {
  const float* in[N_IN];
  float* out;
  char* ws;
  int ph0, ph1;
};
struct Params {
  const char* tab;
  float* out;
  char* ws;
};
constexpr int SMEM_TAB = 73728;
__device__ __forceinline__ const float __attribute__((address_space(1)))* pin_(const char* tab, int i) {
  const unsigned* t = (const unsigned*)tab + 2 * i;
  const unsigned lo = __builtin_amdgcn_readfirstlane(t[0]), hi = __builtin_amdgcn_readfirstlane(t[1]);
  return (const float __attribute__((address_space(1)))*)(((unsigned long long)hi << 32) | lo);
}
#define IN(i) pin_(p.tab, (i))

constexpr int O_Y = 0;
constexpr int O_MLA_CKV = 16777216;
constexpr int O_MLA_KR = O_MLA_CKV + 2097152;
constexpr int O_DIFF_K = O_MLA_KR + 524288;
constexpr int O_DIFF_V = O_DIFF_K + 8388608;
constexpr int O_GQA_K = O_DIFF_V + 8388608;
constexpr int O_GQA_V = O_GQA_K + 2097152;
constexpr int O_LRU = O_GQA_V + 2097152;

constexpr size_t W_MLA_IN = 0;
constexpr size_t W_MLA_UQ = W_MLA_IN + 768 * 1024 * 2;
constexpr size_t W_MLA_UKV = W_MLA_UQ + 1536 * 384 * 2;
constexpr size_t W_MLA_O = W_MLA_UKV + 2048 * 256 * 2;
constexpr size_t W_DIFF_IN = W_MLA_O + 1024 * 1024 * 2;
constexpr size_t W_DIFF_O = W_DIFF_IN + 3072 * 1024 * 2;
constexpr size_t W_GQA_IN = W_DIFF_O + 1024 * 1024 * 2;
constexpr size_t W_GQA_O = W_GQA_IN + 1536 * 1024 * 2;
constexpr size_t W_LRU_IN = W_GQA_O + 1024 * 1024 * 2;
constexpr size_t W_LRU_GATE = W_LRU_IN + 2048 * 1024 * 2;
constexpr size_t W_LRU_OUT = W_LRU_GATE + 4096 * 128 * 2;
constexpr size_t W_FFN_IN = W_LRU_OUT + 1024 * 1024 * 2;
constexpr size_t W_FFN_OUT = W_FFN_IN + (size_t)4 * 5632 * 1024 * 2;
constexpr size_t S_MOD = W_FFN_OUT + (size_t)4 * 1024 * 2816 * 2;
constexpr size_t S_SHW_MIX = S_MOD + 4 * 3 * 6144 * 4;
constexpr size_t S_SHW_FFN = S_SHW_MIX + 4 * 3 * 3072 * 4;
constexpr size_t S_ROWSS = S_SHW_FFN + 4 * 3 * 5632 * 4;
constexpr size_t S_SS_CQ = S_ROWSS + (size_t)8 * 8 * 16384 * 4;
constexpr size_t S_SS_CKV = S_SS_CQ + 3 * 16384 * 4;
constexpr size_t S_ROPE64 = S_SS_CKV + 2 * 16896 * 4;
constexpr size_t S_ROPE128 = S_ROPE64 + 4096 * 32 * 8;
constexpr size_t S_SUMM = S_ROPE128 + 4096 * 64 * 8;
constexpr size_t A_XG = S_SUMM + 2 * 2 * 256 * 1024 * 4;
constexpr size_t A_HB = A_XG + (size_t)16384 * 1024 * 2;
constexpr size_t A_QB = A_HB;
constexpr size_t A_OB_ATT = A_HB + (size_t)16384 * 1536 * 2;
constexpr size_t A_GG = A_HB;
constexpr size_t A_XR = A_HB + (size_t)16384 * 1024 * 2;
constexpr size_t A_ARENA = A_HB + (size_t)16384 * 2816 * 2;
constexpr size_t A_KB = A_ARENA;
constexpr size_t A_VT = A_KB + (size_t)16896 * 1536 * 2;
constexpr size_t A_CQ = A_VT + (size_t)8 * 128 * 16896 * 2;
constexpr size_t A_CKVA = A_CQ + (size_t)16384 * 384 * 2;
constexpr size_t A_ATT_END = A_CKVA + (size_t)16896 * 256 * 2;
constexpr size_t A_OB_LRU = A_ARENA;
constexpr size_t A_LA = A_OB_LRU + (size_t)16384 * 1024 * 2;
constexpr size_t A_U = A_LA + (size_t)2 * 16384 * 1024 * 2;
constexpr size_t A_XRRAW = A_U;
constexpr size_t A_LRU_END = A_U + (size_t)2 * 16384 * 1024 * 2;
constexpr size_t WS_NEED = A_LRU_END > A_ATT_END ? A_LRU_END : A_ATT_END;

constexpr int SMEM_BYTES = 73728 + 512;
constexpr float EPS = 1e-6f;

DI u32 pack2(float a, float b) { v2f v = {a, b}; v2bf r = __builtin_convertvector(v, v2bf); return __builtin_bit_cast(u32, r); }
DI u16 f2bf(float a) { return (u16)(pack2(a, 0.f) & 0xffffu); }
DI float bf2f(u16 v) { return __uint_as_float(((u32)v) << 16); }
DI float bflo(u32 v) { return __uint_as_float(v << 16); }
DI float bfhi(u32 v) { return __uint_as_float(v & 0xffff0000u); }
DI float hsum32(float v) {
  v += __shfl_xor(v, 1); v += __shfl_xor(v, 2); v += __shfl_xor(v, 4); v += __shfl_xor(v, 8); v += __shfl_xor(v, 16);
  return v;
}
DI float wsum64(float v) { v = hsum32(v); v += __shfl_xor(v, 32); return v; }
DI float sigmoidf_(float x) { return __builtin_amdgcn_rcpf(1.f + __expf(-x)); }
DI float siluf_(float x) { return x * __builtin_amdgcn_rcpf(1.f + __expf(-x)); }
DI float geluf_(float x) { const float u = 1.5957691216057308f * (x + 0.044715f * x * x * x); return x * __builtin_amdgcn_rcpf(1.f + __expf(-u)); }

template <int NP> DI float ss_sum(const float* base, int stride, int row) {
  float v[NP];
#pragma unroll
  for (int i = 0; i < NP; ++i) v[i] = base[i * stride + row];
  if (NP == 8) return ((v[0] + v[1]) + (v[2] + v[3])) + ((v[4] + v[5]) + (v[6] + v[7]));
  float s = v[0];
#pragma unroll
  for (int i = 1; i < NP; ++i) s += v[i];
  return s;
}
struct TileInfo { int T0, cr, pos0, kr0, b; bool smp; };
DI TileInfo tile_info(int mt) {
  TileInfo t; t.T0 = mt * 128; t.smp = t.T0 >= 8192;
  if (t.smp) { int u = t.T0 - 8192; t.b = u >> 12; t.pos0 = u & 4095; t.cr = 1 + t.b; t.kr0 = 8192 + t.b * 4352 + 256 + t.pos0; }
  else { t.b = t.T0 >> 8; t.pos0 = t.T0 & 255; t.cr = 0; t.kr0 = t.T0; }
  return t;
}
DI int vt_off(bool smp, int b, int HKV, int vh, int dv, int key) {
  return smp ? 32 * HKV * 128 * 256 + ((b * HKV + vh) * 128 + dv) * 4352 + key : ((b * HKV + vh) * 128 + dv) * 256 + key;
}

#define WSP(T, off) ((T*)(p.ws + (off)))
#define MODP(l, cr, i) (WSP(const float, S_MOD) + ((l) * 3 + (cr)) * 6144 + (i) * 1024)

enum { E_MLA_IN, E_MLA_Q, E_MLA_KV, E_RES_MIX, E_RES_FFN, E_FFN_IN, E_DIFF_IN, E_GQA_IN, E_LRU_IN, E_GATE };

DI void vt_store4(u16* vt, int off, float a, float b, float c, float d) {
  uint2 v; v.x = pack2(a, b); v.y = pack2(c, d); *(uint2*)(vt + off) = v;
}

template <int E>
DI void epilogue(const Params& p, int l, int mt, int nt, f32x16 (&acc)[4]) {
  const int lane = threadIdx.x & 63, w = threadIdx.x >> 6, l32 = lane & 31, hh = lane >> 5;
  const int rbase = w * 32 + 4 * hh;
#define ROWL(r) (rbase + 8 * ((r) >> 2) + ((r) & 3))

  if constexpr (E == E_RES_MIX || E == E_RES_FFN) {
    const TileInfo ti = tile_info(mt);
    float* x = p.out;
    const float* gate = MODP(l, ti.cr, E == E_RES_MIX ? 2 : 5);
    const bool has_next = (E == E_RES_MIX) || (l < 3);
    GF gn = (E == E_RES_MIX) ? IN(I_GN2) + l * 1024 : IN(I_GN1) + (l + 1) * 1024;
    const float* sc = (E == E_RES_MIX) ? MODP(l, ti.cr, 4) : MODP(l + 1, ti.cr, 1);
    float* ssn = WSP(float, S_ROWSS) + (((E == E_RES_MIX) ? 2 * l + 1 : 2 * l + 2) * 8 + nt) * 16384;
    u16* xg = WSP(u16, A_XG);
    float sq[16];
#pragma unroll
    for (int r = 0; r < 16; ++r) sq[r] = 0.f;
#pragma unroll
    for (int nb = 0; nb < 4; ++nb) {
      const int col = nt * 128 + nb * 32 + l32;
      const float gt = gate[col];
      const float gs = has_next ? gn[col] * (1.f + sc[col]) : 0.f;
#pragma unroll
      for (int r = 0; r < 16; ++r) {
        const int T = ti.T0 + ROWL(r);
        const float xn = x[T * 1024 + col] + gt * acc[nb][r];
        x[T * 1024 + col] = xn;
        if (has_next) { xg[T * 1024 + col] = f2bf(xn * gs); sq[r] += xn * xn; }
      }
    }
    if (has_next) {
#pragma unroll
      for (int r = 0; r < 16; ++r) { float s = hsum32(sq[r]); if (l32 == 0) ssn[ti.T0 + ROWL(r)] = s; }
    }
    return;
  }

  if constexpr (E == E_MLA_Q) {
    const TileInfo ti = tile_info(mt);
    GF g = IN(I_MLA_GQK);
    u16* qb = WSP(u16, A_QB);
    if (nt < 8) {
      float sq[16];
#pragma unroll
      for (int r = 0; r < 16; ++r) {
        float s = 0.f;
#pragma unroll
        for (int nb = 0; nb < 4; ++nb) { s += acc[nb][r] * acc[nb][r]; }
        sq[r] = rsqrtf(hsum32(s) * (1.f / 128.f) + EPS);
      }
#pragma unroll
      for (int nb = 0; nb < 4; ++nb) {
        const int c = nb * 32 + l32; const float gg = g[c];
#pragma unroll
        for (int r = 0; r < 16; ++r) qb[(ti.T0 + ROWL(r)) * 1536 + nt * 192 + c] = f2bf(acc[nb][r] * sq[r] * gg);
      }
    } else {
      const float2* rt = WSP(const float2, S_ROPE64);
#pragma unroll
      for (int pr = 0; pr < 2; ++pr) {
        const int h = (nt - 8) * 2 + pr;
        const float g1 = g[128 + l32], g2 = g[160 + l32];
#pragma unroll
        for (int r = 0; r < 16; ++r) {
          float a = acc[2 * pr][r], b = acc[2 * pr + 1][r];
          float n = rsqrtf(hsum32(a * a + b * b) * (1.f / 64.f) + EPS);
          a *= n * g1; b *= n * g2;
          const int T = ti.T0 + ROWL(r);
          if (ti.smp) { float2 cs = rt[(ti.pos0 + ROWL(r)) * 32 + l32]; float a2 = a * cs.x - b * cs.y; b = a * cs.y + b * cs.x; a = a2; }
          qb[T * 1536 + h * 192 + 128 + l32] = f2bf(a);
          qb[T * 1536 + h * 192 + 160 + l32] = f2bf(b);
        }
      }
    }
    return;
  }

  if constexpr (E == E_MLA_KV) {
    const int kr0 = mt * 128;
    const int h = nt >> 1;
    if ((nt & 1) == 0) {
      GF g = IN(I_MLA_GQK) + 192;
      u16* kb = WSP(u16, A_KB);
      float gg[4];
#pragma unroll
      for (int nb = 0; nb < 4; ++nb) gg[nb] = g[nb * 32 + l32];
#pragma unroll
      for (int r = 0; r < 16; ++r) {
        const float t0 = acc[0][r], t1 = acc[1][r], t2 = acc[2][r], t3 = acc[3][r];
        const float n = rsqrtf(hsum32(t0 * t0 + t1 * t1 + t2 * t2 + t3 * t3) * (1.f / 128.f) + EPS);
        u16* d = kb + (kr0 + ROWL(r)) * 1536 + h * 192 + l32;
        d[0] = f2bf(t0 * n * gg[0]); d[32] = f2bf(t1 * n * gg[1]); d[64] = f2bf(t2 * n * gg[2]); d[96] = f2bf(t3 * n * gg[3]);
      }
    } else {
      u16* vt = WSP(u16, A_VT);
      const bool smp = kr0 >= 8192;
      int b, key0;
      if (smp) { int u = kr0 - 8192; b = u / 4352; key0 = u - b * 4352; } else { b = kr0 >> 8; key0 = kr0 & 255; }
#pragma unroll
      for (int nb = 0; nb < 4; ++nb) {
        const int dv = nb * 32 + l32;
#pragma unroll
        for (int g4 = 0; g4 < 4; ++g4) {
          const int off = vt_off(smp, b, 8, h, dv, key0 + rbase + 8 * g4);
          vt_store4(vt, off, acc[nb][4 * g4], acc[nb][4 * g4 + 1], acc[nb][4 * g4 + 2], acc[nb][4 * g4 + 3]);
        }
      }
    }
    return;
  }

  if constexpr (E == E_GATE) {
    const TileInfo ti = tile_info(mt);
    const int d = nt >> 4, blk = (nt >> 1) & 7, half = nt & 1;
    GF bg = IN(I_LRU_BGATE) + d * 2048;
    GF lam = IN(I_LRU_LAM) + d * 1024;
    const u16* xr = WSP(const u16, A_XR);
    u16* la = WSP(u16, A_LA) + (size_t)d * 16384 * 1024;
    u16* uu = WSP(u16, A_U) + (size_t)d * 16384 * 1024;
    const int j0 = blk * 128 + half * 64 + l32;
    const float br0 = bg[j0], bi0 = bg[1024 + j0], br1 = bg[j0 + 32], bi1 = bg[1024 + j0 + 32];
    const float sp0 = -8.f * log1pf(__expf(-lam[j0])), sp1 = -8.f * log1pf(__expf(-lam[j0 + 32]));
#pragma unroll
    for (int r = 0; r < 16; ++r) {
      const int o = (ti.T0 + ROWL(r)) * 1024 + j0;
      const u32 xv0 = xr[o], xv1 = xr[o + 32];
      const float la0 = sigmoidf_(acc[0][r] + br0) * sp0, la1 = sigmoidf_(acc[1][r] + br1) * sp1;
      const float u0 = sqrtf(fmaxf(1.f - __expf(2.f * la0), 0.f)) * sigmoidf_(acc[2][r] + bi0) * bf2f((u16)xv0);
      const float u1 = sqrtf(fmaxf(1.f - __expf(2.f * la1), 0.f)) * sigmoidf_(acc[3][r] + bi1) * bf2f((u16)xv1);
      la[o] = f2bf(la0); la[o + 32] = f2bf(la1);
      uu[o] = f2bf(u0); uu[o + 32] = f2bf(u1);
      if ((r & 3) == 3) __builtin_amdgcn_sched_barrier(0);
    }
    return;
  }

  if constexpr (E == E_MLA_IN || E == E_FFN_IN || E == E_DIFF_IN || E == E_GQA_IN || E == E_LRU_IN) {
    const TileInfo ti = tile_info(mt);
    const int slot = (E == E_FFN_IN) ? 2 * l + 1 : 2 * l;
    const int NW = (E == E_FFN_IN) ? 5632 : 3072;
    const float* ss = WSP(const float, S_ROWSS) + slot * 8 * 16384;
    const float* shw = ((E == E_FFN_IN) ? WSP(const float, S_SHW_FFN) + l * 3 * 5632 : WSP(const float, S_SHW_MIX) + l * 3 * 3072) + ti.cr * NW;
    float rs[16];
#pragma unroll
    for (int r = 0; r < 16; ++r) rs[r] = ss_sum<8>(ss, 16384, ti.T0 + ROWL(r));
#pragma unroll
    for (int r = 0; r < 16; ++r) rs[r] = rsqrtf(rs[r] * (1.f / 1024.f) + EPS);
#pragma unroll
    for (int nb = 0; nb < 4; ++nb) {
      const float bias = shw[nt * 128 + nb * 32 + l32];
#pragma unroll
      for (int r = 0; r < 16; ++r) acc[nb][r] = acc[nb][r] * rs[r] + bias;
    }

    if constexpr (E == E_FFN_IN) {
      u16* hb = WSP(u16, A_HB);
#pragma unroll
      for (int nbp = 0; nbp < 2; ++nbp) {
        const int hc = nt * 64 + nbp * 32 + l32;
#pragma unroll
        for (int r = 0; r < 16; ++r) hb[(size_t)(ti.T0 + ROWL(r)) * 2816 + hc] = f2bf(siluf_(acc[nbp][r]) * acc[nbp + 2][r]);
      }
    }

    if constexpr (E == E_LRU_IN) {
      if (nt < 8) {
        u16* gg = WSP(u16, A_OB_LRU);
#pragma unroll
        for (int nb = 0; nb < 4; ++nb)
#pragma unroll
          for (int r = 0; r < 16; ++r) { gg[(ti.T0 + ROWL(r)) * 1024 + nt * 128 + nb * 32 + l32] = f2bf(geluf_(acc[nb][r])); }
      } else {
        u16* xw = WSP(u16, A_XRRAW);
#pragma unroll
        for (int nb = 0; nb < 4; ++nb)
#pragma unroll
          for (int r = 0; r < 16; ++r) xw[(ti.T0 + ROWL(r)) * 1024 + (nt - 8) * 128 + nb * 32 + l32] = f2bf(acc[nb][r]);
      }
    }

    if constexpr (E == E_MLA_IN) {
      if (nt < 3) {
        GF g = IN(I_MLA_GCQ);
        u16* cq = WSP(u16, A_CQ);
        float* sscq = WSP(float, S_SS_CQ);
        float sq[16];
#pragma unroll
        for (int r = 0; r < 16; ++r) sq[r] = 0.f;
#pragma unroll
        for (int nb = 0; nb < 4; ++nb) {
          const int c = nt * 128 + nb * 32 + l32; const float gg = g[c];
#pragma unroll
          for (int r = 0; r < 16; ++r) { const float v = acc[nb][r]; sq[r] += v * v; cq[(ti.T0 + ROWL(r)) * 384 + c] = f2bf(v * gg); }
        }
#pragma unroll
        for (int r = 0; r < 16; ++r) { float s = hsum32(sq[r]); if (l32 == 0) sscq[nt * 16384 + ti.T0 + ROWL(r)] = s; }
      } else if (nt < 5) {
        GF g = IN(I_MLA_GCKV);
        u16* ca = WSP(u16, A_CKVA);
        float* ssk = WSP(float, S_SS_CKV);
        float* oc = p.out + O_MLA_CKV;
        float sq[16];
#pragma unroll
        for (int r = 0; r < 16; ++r) sq[r] = 0.f;
#pragma unroll
        for (int nb = 0; nb < 4; ++nb) {
          const int c = (nt - 3) * 128 + nb * 32 + l32; const float gg = g[c];
#pragma unroll
          for (int r = 0; r < 16; ++r) {
            const float v = acc[nb][r]; sq[r] += v * v;
            ca[(ti.kr0 + ROWL(r)) * 256 + c] = f2bf(v * gg);
            if (!ti.smp) oc[(ti.T0 + ROWL(r)) * 256 + c] = v * gg;
          }
        }
#pragma unroll
        for (int r = 0; r < 16; ++r) { float s = hsum32(sq[r]); if (l32 == 0) ssk[(nt - 3) * 16896 + ti.kr0 + ROWL(r)] = s; }
      } else {
        GF g = IN(I_MLA_GQK) + 192 + 128;
        const float g1 = g[l32], g2 = g[32 + l32];
        const float2* rt = WSP(const float2, S_ROPE64);
        u16* kb = WSP(u16, A_KB);
        float* okr = p.out + O_MLA_KR;
#pragma unroll
        for (int r = 0; r < 16; ++r) {
          float a = acc[0][r], b = acc[1][r];
          const float n = rsqrtf(hsum32(a * a + b * b) * (1.f / 64.f) + EPS);
          a *= n * g1; b *= n * g2;
          const int rl = ROWL(r);
          if (!ti.smp) { okr[(ti.T0 + rl) * 64 + l32] = a; okr[(ti.T0 + rl) * 64 + 32 + l32] = b; }
          else { float2 cs = rt[(ti.pos0 + rl) * 32 + l32]; float a2 = a * cs.x - b * cs.y; b = a * cs.y + b * cs.x; a = a2; }
          const u16 ua = f2bf(a), ub = f2bf(b);
#pragma unroll
          for (int h = 0; h < 8; ++h) { kb[(ti.kr0 + rl) * 1536 + h * 192 + 128 + l32] = ua; kb[(ti.kr0 + rl) * 1536 + h * 192 + 160 + l32] = ub; }
        }
      }
    }

    if constexpr (E == E_DIFF_IN) {
      const int sec = nt >> 3, h = nt & 7;
      if (sec < 2) {
        GF g = IN(I_DIFF_GQK) + sec * 64;
        const float g1 = g[l32], g2 = g[32 + l32];
        const float2* rt = WSP(const float2, S_ROPE64);
        u16* dst = sec == 0 ? WSP(u16, A_QB) : WSP(u16, A_KB);
        const int row0 = sec == 0 ? ti.T0 : ti.kr0;
        float* ok = p.out + O_DIFF_K;
#pragma unroll
        for (int pr = 0; pr < 2; ++pr) {
#pragma unroll
          for (int r = 0; r < 16; ++r) {
            float a = acc[2 * pr][r], b = acc[2 * pr + 1][r];
            const float n = rsqrtf(hsum32(a * a + b * b) * (1.f / 64.f) + EPS);
            a *= n * g1; b *= n * g2;
            const int rl = ROWL(r);
            const int c = h * 128 + pr * 64 + l32;
            if (sec == 1 && !ti.smp) { ok[(ti.T0 + rl) * 1024 + c] = a; ok[(ti.T0 + rl) * 1024 + c + 32] = b; }
            if (ti.smp) { float2 cs = rt[(ti.pos0 + rl) * 32 + l32]; float a2 = a * cs.x - b * cs.y; b = a * cs.y + b * cs.x; a = a2; }
            dst[(row0 + rl) * 1024 + c] = f2bf(a);
            dst[(row0 + rl) * 1024 + c + 32] = f2bf(b);
          }
        }
      } else {
        u16* vt = WSP(u16, A_VT);
        float* ov = p.out + O_DIFF_V;
#pragma unroll
        for (int nb = 0; nb < 4; ++nb) {
          const int dv = nb * 32 + l32;
#pragma unroll
          for (int g4 = 0; g4 < 4; ++g4) {
            const int key = (ti.smp ? 256 : 0) + ti.pos0 + rbase + 8 * g4;
            vt_store4(vt, vt_off(ti.smp, ti.b, 8, h, dv, key), acc[nb][4 * g4], acc[nb][4 * g4 + 1], acc[nb][4 * g4 + 2], acc[nb][4 * g4 + 3]);
          }
          if (!ti.smp) {
#pragma unroll
            for (int r = 0; r < 16; ++r) ov[(ti.T0 + ROWL(r)) * 1024 + h * 128 + dv] = acc[nb][r];
          }
        }
      }
    }

    if constexpr (E == E_GQA_IN) {
      if (nt < 10) {
        const bool isq = nt < 8;
        const int h = isq ? nt : nt - 8;
        GF g = IN(I_GQA_GQK) + (isq ? 0 : 128);
        const float2* rt = WSP(const float2, S_ROPE128);
        u16* dst = isq ? WSP(u16, A_QB) : WSP(u16, A_KB);
        const int ld = isq ? 1024 : 256;
        const int row0 = isq ? ti.T0 : ti.kr0;
        float* ok = p.out + O_GQA_K;
        float gg[4];
#pragma unroll
        for (int nb = 0; nb < 4; ++nb) gg[nb] = g[nb * 32 + l32];
#pragma unroll
        for (int r = 0; r < 16; ++r) {
          float v0 = acc[0][r], v1 = acc[1][r], v2 = acc[2][r], v3 = acc[3][r];
          const float n = rsqrtf(hsum32(v0 * v0 + v1 * v1 + v2 * v2 + v3 * v3) * (1.f / 128.f) + EPS);
          v0 *= n * gg[0]; v1 *= n * gg[1]; v2 *= n * gg[2]; v3 *= n * gg[3];
          const int rl = ROWL(r);
          if (!isq && !ti.smp) {
            float* o = ok + (ti.T0 + rl) * 256 + h * 128 + l32;
            o[0] = v0; o[32] = v1; o[64] = v2; o[96] = v3;
          }
          if (ti.smp) {
            const float2 c0 = rt[(ti.pos0 + rl) * 64 + l32], c1 = rt[(ti.pos0 + rl) * 64 + 32 + l32];
            const float a0 = v0 * c0.x - v2 * c0.y, b0 = v0 * c0.y + v2 * c0.x;
            const float a1 = v1 * c1.x - v3 * c1.y, b1 = v1 * c1.y + v3 * c1.x;
            v0 = a0; v2 = b0; v1 = a1; v3 = b1;
          }
          u16* d = dst + (row0 + rl) * ld + h * 128 + l32;
          d[0] = f2bf(v0); d[32] = f2bf(v1); d[64] = f2bf(v2); d[96] = f2bf(v3);
        }
      } else {
        const int h = nt - 10;
        u16* vt = WSP(u16, A_VT);
        float* ov = p.out + O_GQA_V;
#pragma unroll
        for (int nb = 0; nb < 4; ++nb) {
          const int dv = nb * 32 + l32;
#pragma unroll
          for (int g4 = 0; g4 < 4; ++g4) {
            const int key = (ti.smp ? 256 : 0) + ti.pos0 + rbase + 8 * g4;
            vt_store4(vt, vt_off(ti.smp, ti.b, 2, h, dv, key), acc[nb][4 * g4], acc[nb][4 * g4 + 1], acc[nb][4 * g4 + 2], acc[nb][4 * g4 + 3]);
          }
          if (!ti.smp) {
#pragma unroll
            for (int r = 0; r < 16; ++r) ov[(ti.T0 + ROWL(r)) * 256 + h * 128 + dv] = acc[nb][r];
          }
        }
      }
    }
    return;
  }
#undef ROWL
}

template <int E>
DI void gemm_phase(const Params& p, int l, const u16* A, int lda, const u16* Bt, int ldb, int K, int mtiles, int ntiles, char* smem,
                   int bstart = 0, int nblk = 0) {
  const int tid = threadIdx.x, lane = tid & 63, w = tid >> 6, l32 = lane & 31, hh = lane >> 5;
  u16* sm = (u16*)smem;
  const int total = mtiles * ntiles;
  const int nk = K >> 6;
  const int lrow = tid >> 3, lc8 = (tid & 7) * 8;
  if (nblk == 0) nblk = gridDim.x;
  int bid = (int)blockIdx.x - bstart; if (bid < 0) bid += gridDim.x;
  for (int t = bid; t < total; t += nblk) {
    const int g = t / (8 * ntiles); const int rem = t - g * 8 * ntiles; const int gsz = min(8, mtiles - g * 8);
    const int mt = g * 8 + rem % gsz, nt = rem / gsz;
    const int akoff = (E == E_GATE) ? ((nt >> 1) & 7) * 128 : 0;
    const char* Au = (const char*)(A + (size_t)(mt * 128) * lda + akoff);
    const char* Bu = (const char*)(Bt + (size_t)(nt * 128) * ldb);
    const u32 avo = (u32)((lrow * lda + lc8) * 2), bvo = (u32)((lrow * ldb + lc8) * 2);
    const int swz = (l32 >> 2) & 3;
    const u32 g_aoff = (u32)(((tid >> 2) * lda + (((tid & 3) ^ ((tid >> 4) & 3)) * 8)) * 2);
    const u32 g_boff = (u32)(((tid >> 2) * ldb + (((tid & 3) ^ ((tid >> 4) & 3)) * 8)) * 2);
    char* const smb = (char*)sm;
#define G_ISSUE(ST, KT)                                                                                          \
  _Pragma("unroll") for (int i = 0; i < 2; ++i) {                                                                \
    __builtin_amdgcn_global_load_lds((const unsigned*)(Au + (size_t)i * 64 * lda * 2 + (size_t)(KT) * 64 + g_aoff), \
                                     (unsigned*)(smb + (ST) * 16384 + tid * 16 + i * 4096), 16, 0, 0);            \
    __builtin_amdgcn_global_load_lds((const unsigned*)(Bu + (size_t)i * 64 * ldb * 2 + (size_t)(KT) * 64 + g_boff), \
                                     (unsigned*)(smb + (ST) * 16384 + 8192 + tid * 16 + i * 4096), 16, 0, 0);     \
  }
    f32x16 acc[4];
#pragma unroll
    for (int nb = 0; nb < 4; ++nb)
#pragma unroll
      for (int r = 0; r < 16; ++r) acc[nb][r] = 0.f;
    const int nk32 = K >> 5;
    G_ISSUE(0, 0)
    if (nk32 > 1) G_ISSUE(1, 1)
    if (nk32 > 2) G_ISSUE(2, 2)
    for (int kt = 0; kt < nk32; ++kt) {
      const int rem = nk32 - 1 - kt;
      if (rem >= 2) asm volatile("s_waitcnt vmcnt(8)" ::: "memory");
      else if (rem == 1) asm volatile("s_waitcnt vmcnt(4)" ::: "memory");
      else asm volatile("s_waitcnt vmcnt(0)" ::: "memory");
      __builtin_amdgcn_s_barrier();
      if (kt + 3 < nk32) G_ISSUE((kt + 3) & 3, kt + 3)
      const char* st = smb + (kt & 3) * 16384;
      bf16x8 fa0, fb0[4], fa1, fb1[4];
      fa0 = *(const bf16x8*)(st + (w * 32 + l32) * 64 + (((0 + hh) ^ swz) * 16));
#pragma unroll
      for (int nb = 0; nb < 4; ++nb) fb0[nb] = *(const bf16x8*)(st + 8192 + (nb * 32 + l32) * 64 + (((0 + hh) ^ swz) * 16));
      fa1 = *(const bf16x8*)(st + (w * 32 + l32) * 64 + (((2 + hh) ^ swz) * 16));
#pragma unroll
      for (int nb = 0; nb < 4; ++nb) fb1[nb] = *(const bf16x8*)(st + 8192 + (nb * 32 + l32) * 64 + (((2 + hh) ^ swz) * 16));
      __builtin_amdgcn_s_setprio(1);
#pragma unroll
      for (int nb = 0; nb < 4; ++nb) acc[nb] = __builtin_amdgcn_mfma_f32_32x32x16_bf16(fa0, fb0[nb], acc[nb], 0, 0, 0);
#pragma unroll
      for (int nb = 0; nb < 4; ++nb) acc[nb] = __builtin_amdgcn_mfma_f32_32x32x16_bf16(fa1, fb1[nb], acc[nb], 0, 0, 0);
      __builtin_amdgcn_s_setprio(0);
    }
    __builtin_amdgcn_s_barrier();
#undef G_ISSUE
    epilogue<E>(p, l, mt, nt, acc);
  }
}

template <int DQ, int NSUB>
DI void attn_phase(const Params& p, int ldq, int ldk, int HKV, int KVG, float scale, float lam_init, char* smem) {
  constexpr int LDK = DQ + 8;
  constexpr int NKC = DQ / 8;
  constexpr int KCH = (64 * NKC) / 256;
  constexpr int NQF = DQ / 16;
  const int tid = threadIdx.x, lane = tid & 63, w = tid >> 6, l32 = lane & 31, hh = lane >> 5;
  const u16* Q = WSP(const u16, A_QB);
  const u16* Kb = WSP(const u16, A_KB);
  const u16* Vt = WSP(const u16, A_VT);
  u16* O = WSP(u16, A_OB_ATT);
  u16* sK = (u16*)smem;
  u16* sV = sK + 64 * LDK;
  u32* stash = (u32*)(sV + 128 * 72);
  const float sc2 = scale * 1.4426950408889634f;
  const int perm = (l32 & ~12) | ((l32 & 8) >> 1) | ((l32 & 4) << 1);
  const int NH = 8;
  const int n_s = NH * 2 * 32, n_c = NH * 32 * 2;
  for (int it = blockIdx.x; it < n_s + n_c; it += gridDim.x) {
    bool smp; int b, h, qt;
    if (it < n_s) { smp = true; qt = it & 31; h = (it >> 5) & 7; b = it >> 8; }
    else { int u = it - n_s; smp = false; qt = u & 1; h = (u >> 1) & 7; b = u >> 4; }
    const int T0 = (smp ? 8192 + b * 4096 : b * 256) + qt * 128;
    const int KR0 = smp ? 8192 + b * 4352 : b * 256;
    const int nkeys = smp ? 4352 : 256;
    const int ntile = nkeys >> 6;
    const int vh = h / KVG;
    const u16* vbase = Vt + vt_off(smp, b, HKV, vh, 0, 0);
#pragma unroll 1
    for (int sub = 0; sub < NSUB; ++sub) {
      const int qoff = (DQ == 192) ? h * 192 : (NSUB == 2 ? h * 128 + sub * 64 : h * 128);
      const int koff = (DQ == 192) ? h * 192 : (NSUB == 2 ? h * 128 + sub * 64 : vh * 128);
      bf16x8 qf[NQF];
      {
        const u16* qp = Q + (size_t)(T0 + w * 32 + l32) * ldq + qoff + hh * 8;
#pragma unroll
        for (int kk = 0; kk < NQF; ++kk) qf[kk] = *(const bf16x8*)(qp + kk * 16);
      }
      f32x16 oacc[4];
#pragma unroll
      for (int db = 0; db < 4; ++db)
#pragma unroll
        for (int r = 0; r < 16; ++r) oacc[db][r] = 0.f;
      float mrun = -1e30f, lsum = 0.f;
      u32x4 rk[KCH], rv[4];
      constexpr int NP16 = (DQ >= 128) ? 4 : 0;
      constexpr int NP8 = (DQ == 128) ? 0 : 2;
      constexpr int C8 = (DQ == 192) ? 128 : 0;
      const u32 kvo16 = (u32)(((tid >> 4) * ldk + (tid & 15) * 8) * 2);
      const u32 kvo8 = (u32)(((tid >> 3) * ldk + (tid & 7) * 8 + C8) * 2);
      const u32 vvo = (u32)(((tid >> 3) * nkeys + (tid & 7) * 8) * 2);
      u16* const lk16 = sK + (tid >> 4) * LDK + (tid & 15) * 8;
      u16* const lk8 = sK + (tid >> 3) * LDK + (tid & 7) * 8 + C8;
      u16* const lv = sV + (tid >> 3) * 72 + (tid & 7) * 8;
      const char* kuni = (const char*)(Kb + (size_t)KR0 * ldk + koff);
      const char* vuni = (const char*)vbase;
#define ATT_LOAD(jj)                                                                                              \
  {                                                                                                               \
    const char* ku = kuni + (size_t)(jj) * 64 * ldk * 2;                                                          \
    _Pragma("unroll") for (int i = 0; i < NP16; ++i) rk[i] = *(const u32x4*)(ku + (size_t)i * 16 * ldk * 2 + kvo16); \
    _Pragma("unroll") for (int i = 0; i < NP8; ++i) rk[NP16 + i] = *(const u32x4*)(ku + (size_t)i * 32 * ldk * 2 + kvo8); \
    const char* vu = vuni + (size_t)(jj) * 128;                                                                   \
    _Pragma("unroll") for (int i = 0; i < 4; ++i) rv[i] = *(const u32x4*)(vu + (size_t)i * 32 * nkeys * 2 + vvo);  \
  }
      ATT_LOAD(0)
      for (int j = 0; j < ntile; ++j) {
        __syncthreads();
#pragma unroll
        for (int i = 0; i < NP16; ++i) *(u32x4*)(lk16 + i * 16 * LDK) = rk[i];
#pragma unroll
        for (int i = 0; i < NP8; ++i) *(u32x4*)(lk8 + i * 32 * LDK) = rk[NP16 + i];
#pragma unroll
        for (int i = 0; i < 4; ++i) *(u32x4*)(lv + i * 32 * 72) = rv[i];
        __syncthreads();
        if (j + 1 < ntile) ATT_LOAD(j + 1)
#pragma unroll(DQ == 192 ? 1 : 2)
        for (int mb = 0; mb < 2; ++mb) {
          f32x16 sacc;
#pragma unroll
          for (int r = 0; r < 16; ++r) sacc[r] = 0.f;
#pragma unroll
          for (int kk = 0; kk < NQF; ++kk) {
            const bf16x8 a = *(const bf16x8*)(sK + (mb * 32 + perm) * LDK + kk * 16 + hh * 8);
            sacc = __builtin_amdgcn_mfma_f32_32x32x16_bf16(a, qf[kk], sacc, 0, 0, 0);
          }
          float tmax = sacc[0];
#pragma unroll
          for (int r = 1; r < 16; ++r) tmax = fmaxf(tmax, sacc[r]);
          tmax = fmaxf(tmax, __shfl_xor(tmax, 32)) * sc2;
          if (__any(tmax > mrun)) {
            const float mnew = fmaxf(mrun, tmax);
            const float alpha = __builtin_amdgcn_exp2f(mrun - mnew);
            mrun = mnew;
            lsum *= alpha;
#pragma unroll
            for (int db = 0; db < 4; ++db)
#pragma unroll
              for (int r = 0; r < 16; ++r) oacc[db][r] *= alpha;
          }
          v2f psv = {0.f, 0.f};
          const v2f scv = {sc2, sc2}, mv = {mrun, mrun};
#pragma unroll
          for (int r2 = 0; r2 < 8; ++r2) {
            v2f x = {sacc[2 * r2], sacc[2 * r2 + 1]};
            x = x * scv - mv;
            v2f e = {__builtin_amdgcn_exp2f(x.x), __builtin_amdgcn_exp2f(x.y)};
            sacc[2 * r2] = e.x; sacc[2 * r2 + 1] = e.y;
            psv += e;
          }
          lsum += psv.x + psv.y;
#pragma unroll
          for (int s2 = 0; s2 < 2; ++s2) {
            u32x4 pk;
            pk.x = pack2(sacc[8 * s2 + 0], sacc[8 * s2 + 1]); pk.y = pack2(sacc[8 * s2 + 2], sacc[8 * s2 + 3]);
            pk.z = pack2(sacc[8 * s2 + 4], sacc[8 * s2 + 5]); pk.w = pack2(sacc[8 * s2 + 6], sacc[8 * s2 + 7]);
            const bf16x8 pf = __builtin_bit_cast(bf16x8, pk);
#pragma unroll
            for (int db = 0; db < 4; ++db) {
              const bf16x8 a = *(const bf16x8*)(sV + (db * 32 + l32) * 72 + (2 * mb + s2) * 16 + hh * 8);
              oacc[db] = __builtin_amdgcn_mfma_f32_32x32x16_bf16(a, pf, oacc[db], 0, 0, 0);
            }
          }
        }
      }
      lsum += __shfl_xor(lsum, 32);
      const float inv = 1.f / lsum;
      if (NSUB == 2 && sub == 0) {
#pragma unroll
        for (int db = 0; db < 4; ++db)
#pragma unroll
          for (int r2 = 0; r2 < 8; ++r2) stash[((w * 4 + db) * 8 + r2) * 64 + lane] = pack2(oacc[db][2 * r2] * inv, oacc[db][2 * r2 + 1] * inv);
      } else if (NSUB == 2) {
        float lamf;
        {
          GF lm = IN(I_DIFF_LAM);
          const float a = wsum64(lm[lane] * lm[64 + lane]), b = wsum64(lm[128 + lane] * lm[192 + lane]);
          lamf = (__expf(a) - __expf(b) + lam_init) * inv;
        }
        float s = 0.f;
#pragma unroll
        for (int db = 0; db < 4; ++db) {
#pragma unroll
          for (int r2 = 0; r2 < 8; ++r2) {
            const u32 sv = stash[((w * 4 + db) * 8 + r2) * 64 + lane];
            const float v0 = bflo(sv) - lamf * oacc[db][2 * r2], v1 = bfhi(sv) - lamf * oacc[db][2 * r2 + 1];
            s += v0 * v0 + v1 * v1;
          }
          __builtin_amdgcn_sched_barrier(0);
        }
        s += __shfl_xor(s, 32);
        const float n = rsqrtf(s * (1.f / 128.f) + EPS) * (1.f - lam_init);
        GF gs = IN(I_DIFF_GSUB);
        u16* op = O + (size_t)(T0 + w * 32 + l32) * 1024 + h * 128 + 4 * hh;
#pragma unroll
        for (int db = 0; db < 4; ++db) {
#pragma unroll
          for (int g4 = 0; g4 < 4; ++g4) {
            const f32x4v gv = *(const GAS f32x4v*)(gs + db * 32 + 8 * g4 + 4 * hh);
            const u32 s0 = stash[((w * 4 + db) * 8 + 2 * g4) * 64 + lane], s1 = stash[((w * 4 + db) * 8 + 2 * g4 + 1) * 64 + lane];
            uint2 v;
            v.x = pack2((bflo(s0) - lamf * oacc[db][4 * g4]) * n * gv.x, (bfhi(s0) - lamf * oacc[db][4 * g4 + 1]) * n * gv.y);
            v.y = pack2((bflo(s1) - lamf * oacc[db][4 * g4 + 2]) * n * gv.z, (bfhi(s1) - lamf * oacc[db][4 * g4 + 3]) * n * gv.w);
            *(uint2*)(op + db * 32 + 8 * g4) = v;
          }
          __builtin_amdgcn_sched_barrier(0);
        }
      } else {
#pragma unroll
        for (int db = 0; db < 4; ++db)
#pragma unroll
          for (int r = 0; r < 16; ++r) oacc[db][r] *= inv;
      }
      if (NSUB == 1) {
        u16* op = O + (size_t)(T0 + w * 32 + l32) * 1024 + h * 128 + 4 * hh;
#pragma unroll
        for (int db = 0; db < 4; ++db)
#pragma unroll
          for (int g4 = 0; g4 < 4; ++g4) {
            uint2 v; v.x = pack2(oacc[db][4 * g4], oacc[db][4 * g4 + 1]); v.y = pack2(oacc[db][4 * g4 + 2], oacc[db][4 * g4 + 3]);
            *(uint2*)(op + db * 32 + 8 * g4) = v;
          }
      }
    }
  }
}

template <class F>
DI void convert_T(GF src, u16* dst, int K, int N, F idx, char* smem, int& rot) {
  float* sm = (float*)smem;
  const int tid = threadIdx.x, tx = tid & 63, ty = tid >> 6;
  const int kt = K >> 6, ntl = N >> 6, total = kt * ntl;
  int start = (int)blockIdx.x - (rot % (int)gridDim.x); if (start < 0) start += gridDim.x;
  rot += total;
  for (int t = start; t < total; t += gridDim.x) {
    const int k0 = (t % kt) * 64, n0 = (t / kt) * 64;
    const int ln = (tid & 15) * 4, lk = tid >> 4;
#pragma unroll
    for (int i = 0; i < 4; ++i) {
      const int k = k0 + lk + 16 * i; const int id = idx(k, n0 + ln);
      f32x4v v = {0.f, 0.f, 0.f, 0.f};
      if (id >= 0) v = *(const GAS f32x4v*)(src + id);
      float* d = sm + (lk + 16 * i) * 65 + ln;
      d[0] = v.x; d[1] = v.y; d[2] = v.z; d[3] = v.w;
    }
    __syncthreads();
    const int sk = (tid & 7) * 8, sn = tid >> 3;
#pragma unroll
    for (int i = 0; i < 2; ++i) {
      const int nn = sn + 32 * i;
      u32x4 o;
      o.x = pack2(sm[(sk + 0) * 65 + nn], sm[(sk + 1) * 65 + nn]); o.y = pack2(sm[(sk + 2) * 65 + nn], sm[(sk + 3) * 65 + nn]);
      o.z = pack2(sm[(sk + 4) * 65 + nn], sm[(sk + 5) * 65 + nn]); o.w = pack2(sm[(sk + 6) * 65 + nn], sm[(sk + 7) * 65 + nn]);
      *(u32x4*)(dst + (size_t)(n0 + nn) * K + k0 + sk) = o;
    }
    __syncthreads();
  }
}

DI void phase0(const Params& p, char* smem) {
  const int tid = threadIdx.x;
  const int gtid = blockIdx.x * 256 + tid, gsz = gridDim.x * 256;
  {
    float* sil = (float*)smem;
    float* red = sil + 3072;
    for (int i = tid; i < 3072; i += 256) {
      const int cr = i >> 10, k = i & 1023;
      const float v = cr == 0 ? IN(I_CCTX)[k] : IN(I_C)[(cr - 1) * 1024 + k];
      sil[i] = siluf_(v);
    }
    __syncthreads();
    const int c4 = tid & 15, kg = tid >> 4;
    for (int it = blockIdx.x; it < 384; it += gridDim.x) {
      const int l = it / 96, cg0 = (it % 96) * 64;
      GF wp = IN(I_WMOD) + (size_t)l * 1024 * 6144 + (size_t)(kg * 64) * 6144 + cg0 + c4 * 4;
      float a0[4] = {0, 0, 0, 0}, a1[4] = {0, 0, 0, 0}, a2[4] = {0, 0, 0, 0};
#pragma unroll 8
      for (int k = 0; k < 64; ++k) {
        const f32x4v wv = *(const GAS f32x4v*)(wp + (size_t)k * 6144);
        const float s0 = sil[kg * 64 + k], s1 = sil[1024 + kg * 64 + k], s2 = sil[2048 + kg * 64 + k];
        a0[0] += s0 * wv.x; a0[1] += s0 * wv.y; a0[2] += s0 * wv.z; a0[3] += s0 * wv.w;
        a1[0] += s1 * wv.x; a1[1] += s1 * wv.y; a1[2] += s1 * wv.z; a1[3] += s1 * wv.w;
        a2[0] += s2 * wv.x; a2[1] += s2 * wv.y; a2[2] += s2 * wv.z; a2[3] += s2 * wv.w;
      }
#pragma unroll
      for (int q = 0; q < 4; ++q) { red[(kg * 3 + 0) * 64 + c4 * 4 + q] = a0[q]; red[(kg * 3 + 1) * 64 + c4 * 4 + q] = a1[q]; red[(kg * 3 + 2) * 64 + c4 * 4 + q] = a2[q]; }
      __syncthreads();
      if (tid < 192) {
        const int cr = tid >> 6, c = tid & 63;
        float s = 0.f;
#pragma unroll
        for (int g = 0; g < 16; ++g) s += red[(g * 3 + cr) * 64 + c];
        WSP(float, S_MOD)[(l * 3 + cr) * 6144 + cg0 + c] = s + IN(I_BMOD)[l * 6144 + cg0 + c];
      }
      __syncthreads();
    }
  }
  {
    float* sk = WSP(float, S_SS_CKV);
    for (int i = gtid; i < 512; i += gsz) {
      const int row = 8192 + (i >> 8) * 4352 + (i & 255);
      sk[row] = 256.f * (1.f - EPS); sk[16896 + row] = 0.f;
    }
  }
  {
    float2* r64 = WSP(float2, S_ROPE64);
    for (int i = gtid; i < 4096 * 32; i += gsz) {
      const int pos = i >> 5, j = i & 31;
      const float inv = powf(10000.f, -(float)(j & 15) / 16.f);
      const float ang = (float)(j < 16 ? (pos >> 6) : (pos & 63)) * inv;
      float s, c; sincosf(ang, &s, &c); r64[i] = make_float2(c, s);
    }
    float2* r128 = WSP(float2, S_ROPE128);
    for (int i = gtid; i < 4096 * 64; i += gsz) {
      const int pos = i >> 6, j = i & 63;
      const float inv = powf(10000.f, -(float)(j & 31) / 32.f);
      const float ang = (float)(j < 32 ? (pos >> 6) : (pos & 63)) * inv;
      float s, c; sincosf(ang, &s, &c); r128[i] = make_float2(c, s);
    }
  }
  {
    u16* ca = WSP(u16, A_CKVA);
    GF src = IN(I_CMLA_CKV);
    for (int i = gtid; i < 2 * 256 * 256; i += gsz) {
      const int c = i & 255, s = (i >> 8) & 255, b = i >> 16;
      ca[(8192 + b * 4352 + s) * 256 + c] = f2bf(src[i]);
    }
  }
  int rot = 384;
  convert_T(IN(I_MLA_WIN), WSP(u16, W_MLA_IN), 1024, 768, [](int k, int n) { return n < 704 ? k * 704 + n : -1; }, smem, rot);
  convert_T(IN(I_MLA_WUQ), WSP(u16, W_MLA_UQ), 384, 1536,
            [](int k, int n) { return n < 1024 ? k * 1536 + (n >> 7) * 192 + (n & 127) : k * 1536 + ((n - 1024) >> 6) * 192 + 128 + (n & 63); }, smem, rot);
  convert_T(IN(I_MLA_WUKV), WSP(u16, W_MLA_UKV), 256, 2048, [](int k, int n) { return k * 2048 + n; }, smem, rot);
  convert_T(IN(I_MLA_WO), WSP(u16, W_MLA_O), 1024, 1024, [](int k, int n) { return k * 1024 + n; }, smem, rot);
  convert_T(IN(I_DIFF_WIN), WSP(u16, W_DIFF_IN), 1024, 3072, [](int k, int n) { return k * 3072 + n; }, smem, rot);
  convert_T(IN(I_DIFF_WO), WSP(u16, W_DIFF_O), 1024, 1024, [](int k, int n) { return k * 1024 + n; }, smem, rot);
  convert_T(IN(I_GQA_WIN), WSP(u16, W_GQA_IN), 1024, 1536, [](int k, int n) { return k * 1536 + n; }, smem, rot);
  convert_T(IN(I_GQA_WO), WSP(u16, W_GQA_O), 1024, 1024, [](int k, int n) { return k * 1024 + n; }, smem, rot);
  convert_T(IN(I_LRU_WIN), WSP(u16, W_LRU_IN), 1024, 2048, [](int k, int n) { return k * 2048 + n; }, smem, rot);
  convert_T(IN(I_LRU_WGATE), WSP(u16, W_LRU_GATE), 128, 4096,
            [](int k, int n) {
              const int T = n >> 7, wq = n & 127, g = wq >> 6, jj = (T & 1) * 64 + (wq & 63), blk = (T >> 1) & 7, d = T >> 4;
              return (((d * 2 + g) * 8 + blk) * 128 + k) * 128 + jj;
            }, smem, rot);
  convert_T(IN(I_LRU_WOUT), WSP(u16, W_LRU_OUT), 1024, 1024, [](int k, int n) { return k * 1024 + n; }, smem, rot);
  for (int l = 0; l < 4; ++l) {
    convert_T(IN(I_WFFN_IN) + (size_t)l * 1024 * 5632, WSP(u16, W_FFN_IN) + (size_t)l * 5632 * 1024, 1024, 5632,
              [](int k, int n) { const int T = n >> 7, wq = n & 127; return k * 5632 + (wq >> 6) * 2816 + T * 64 + (wq & 63); }, smem, rot);
    convert_T(IN(I_WFFN_OUT) + (size_t)l * 2816 * 1024, WSP(u16, W_FFN_OUT) + (size_t)l * 1024 * 2816, 2816, 1024,
              [](int k, int n) { return k * 1024 + n; }, smem, rot);
  }
}

DI void shw_one(const Params& p, const u16* Wt, int N, int stride, const float* shift  , float* dst) {
  const int lane = threadIdx.x & 63;
  const int gw = blockIdx.x * 4 + (threadIdx.x >> 6), nw = gridDim.x * 4;
  float s0[16], s1[16], s2[16];
#pragma unroll
  for (int i = 0; i < 16; ++i) { s0[i] = shift[lane * 16 + i]; s1[i] = shift[6144 + lane * 16 + i]; s2[i] = shift[12288 + lane * 16 + i]; }
  for (int n = gw; n < N; n += nw) {
    const uint4 w0 = *(const uint4*)(Wt + (size_t)n * 1024 + lane * 16);
    const uint4 w1 = *(const uint4*)(Wt + (size_t)n * 1024 + lane * 16 + 8);
    const u32 wv[8] = {w0.x, w0.y, w0.z, w0.w, w1.x, w1.y, w1.z, w1.w};
    float a0 = 0.f, a1 = 0.f, a2 = 0.f;
#pragma unroll
    for (int i = 0; i < 8; ++i) {
      const float lo = bflo(wv[i]), hi = bfhi(wv[i]);
      a0 += lo * s0[2 * i] + hi * s0[2 * i + 1]; a1 += lo * s1[2 * i] + hi * s1[2 * i + 1]; a2 += lo * s2[2 * i] + hi * s2[2 * i + 1];
    }
    a0 = wsum64(a0); a1 = wsum64(a1); a2 = wsum64(a2);
    if (lane == 0) { dst[n] = a0; dst[stride + n] = a1; dst[2 * stride + n] = a2; }
  }
}

DI void phase1(const Params& p) {
  const int lane = threadIdx.x & 63;
  const int gw = blockIdx.x * 4 + (threadIdx.x >> 6), nw = gridDim.x * 4;
  for (int T = gw; T < 16384; T += nw) {
    GF xs = T < 8192 ? IN(I_XP) + (size_t)T * 1024 : IN(I_XS) + (size_t)(T - 8192) * 1024;
    const int cr = T < 8192 ? 0 : 1 + ((T - 8192) >> 12);
    const float* sc = MODP(0, cr, 1);
    GF gn = IN(I_GN1);
    float ss = 0.f;
#pragma unroll
    for (int i = 0; i < 4; ++i) {
      const int c = lane * 4 + 256 * i;
      const f32x4v v = *(const GAS f32x4v*)(xs + c);
      const float4 s4 = *(const float4*)(sc + c);
      const f32x4v g4 = *(const GAS f32x4v*)(gn + c);
      ss += v.x * v.x + v.y * v.y + v.z * v.z + v.w * v.w;
      *(f32x4v*)(p.out + (size_t)T * 1024 + c) = v;
      uint2 o; o.x = pack2(v.x * g4.x * (1.f + s4.x), v.y * g4.y * (1.f + s4.y)); o.y = pack2(v.z * g4.z * (1.f + s4.z), v.w * g4.w * (1.f + s4.w));
      *(uint2*)(WSP(u16, A_XG) + (size_t)T * 1024 + c) = o;
    }
    ss = wsum64(ss);
    if (lane < 8) WSP(float, S_ROWSS)[lane * 16384 + T] = lane == 0 ? ss : 0.f;
  }
  shw_one(p, WSP(const u16, W_MLA_IN), 768, 3072, MODP(0, 0, 0), WSP(float, S_SHW_MIX) + 0 * 3 * 3072);
  shw_one(p, WSP(const u16, W_DIFF_IN), 3072, 3072, MODP(1, 0, 0), WSP(float, S_SHW_MIX) + 1 * 3 * 3072);
  shw_one(p, WSP(const u16, W_GQA_IN), 1536, 3072, MODP(2, 0, 0), WSP(float, S_SHW_MIX) + 2 * 3 * 3072);
  shw_one(p, WSP(const u16, W_LRU_IN), 2048, 3072, MODP(3, 0, 0), WSP(float, S_SHW_MIX) + 3 * 3 * 3072);
  for (int l = 0; l < 4; ++l)
    shw_one(p, WSP(const u16, W_FFN_IN) + (size_t)l * 5632 * 1024, 5632, 5632, MODP(l, 0, 3), WSP(float, S_SHW_FFN) + l * 3 * 5632);
}

DI void cache_prep_mla(const Params& p) {
  const int gtid = blockIdx.x * 256 + threadIdx.x, gsz = gridDim.x * 256;
  u16* kb = WSP(u16, A_KB);
  GF src = IN(I_CMLA_KR);
  for (int i = gtid; i < 2 * 256 * 64 * 8; i += gsz) {
    const int j = i & 63, h = (i >> 6) & 7, s = (i >> 9) & 255, b = i >> 17;
    kb[(8192 + b * 4352 + s) * 1536 + h * 192 + 128 + j] = f2bf(src[(b * 256 + s) * 64 + j]);
  }
}
DI void cache_prep_kv(const Params& p, GF ck, GF cv, int ldk, int HKV) {
  const int gtid = blockIdx.x * 256 + threadIdx.x, gsz = gridDim.x * 256;
  u16* kb = WSP(u16, A_KB);
  u16* vt = WSP(u16, A_VT);
  const int nk = 2 * 256 * ldk;
  for (int i = gtid; i < nk; i += gsz) {
    const int c = i % ldk, s = (i / ldk) & 255, b = i / (ldk * 256);
    kb[(8192 + b * 4352 + s) * ldk + c] = f2bf(ck[i]);
  }
  const int nv = 2 * 256 * HKV * 128;
  for (int i = gtid; i < nv; i += gsz) {
    const int dv = i & 127, h = (i >> 7) % HKV, s = (i / (128 * HKV)) & 255, b = i / (128 * HKV * 256);
    vt[vt_off(true, b, HKV, h, dv, s)] = f2bf(cv[i]);
  }
}

DI void lru_conv(const Params& p) {
  const int gtid = blockIdx.x * 256 + threadIdx.x, gsz = gridDim.x * 256;
  const u16* xw = WSP(const u16, A_XRRAW);
  u16* xr = WSP(u16, A_XR);
  GF cw = IN(I_LRU_CONVW);
  GF cb = IN(I_LRU_CONVB);
  for (int i = gtid; i < 16384 * 128; i += gsz) {
    const int T = i >> 7, c0 = (i & 127) * 8;
    int pos, S;
    if (T < 8192) { pos = T & 255; S = 256; } else { pos = (T - 8192) & 4095; S = 4096; }
    float y[8];
#pragma unroll
    for (int q = 0; q < 8; ++q) y[q] = cb[c0 + q];
#pragma unroll
    for (int t = 0; t < 4; ++t) {
      const int pp = pos + t - 1;
      if (pp >= 0 && pp < S) {
        const uint4 v = *(const uint4*)(xw + (size_t)(T + t - 1) * 1024 + c0);
        const f32x4v w0 = *(const GAS f32x4v*)(cw + t * 1024 + c0), w1 = *(const GAS f32x4v*)(cw + t * 1024 + c0 + 4);
        y[0] += bflo(v.x) * w0.x; y[1] += bfhi(v.x) * w0.y; y[2] += bflo(v.y) * w0.z; y[3] += bfhi(v.y) * w0.w;
        y[4] += bflo(v.z) * w1.x; y[5] += bfhi(v.z) * w1.y; y[6] += bflo(v.w) * w1.z; y[7] += bfhi(v.w) * w1.w;
      }
    }
    uint4 o; o.x = pack2(y[0], y[1]); o.y = pack2(y[2], y[3]); o.z = pack2(y[4], y[5]); o.w = pack2(y[6], y[7]);
    *(uint4*)(xr + (size_t)T * 1024 + c0) = o;
  }
}

DI void lru_summ(const Params& p) {
  const u16* la = WSP(const u16, A_LA);
  const u16* uu = WSP(const u16, A_U);
  float* P = WSP(float, S_SUMM);
  float* H = P + 2 * 256 * 1024;
  for (int it = blockIdx.x; it < 2048; it += gridDim.x) {
    const int d = it >> 10, c = (it >> 2) & 255, j = (it & 3) * 256 + threadIdx.x;
    const size_t base = (size_t)d * 16384 * 1024 + (size_t)(c * 64) * 1024 + j;
    float h = 0.f, sl = 0.f;
#pragma unroll 8
    for (int t = 0; t < 64; ++t) {
      const int tt = d == 0 ? t : 63 - t;
      const float lg = bf2f(la[base + tt * 1024]);
      h = __expf(lg) * h + bf2f(uu[base + tt * 1024]);
      sl += lg;
    }
    P[(d * 256 + c) * 1024 + j] = __expf(sl);
    H[(d * 256 + c) * 1024 + j] = h;
  }
}

DI void lru_final(const Params& p, char* smem) {
  float* hfs = (float*)smem;
  const u16* la = WSP(const u16, A_LA);
  const u16* uu = WSP(const u16, A_U);
  u16* ob = WSP(u16, A_OB_LRU);
  const float* P = WSP(const float, S_SUMM);
  const float* H = P + 2 * 256 * 1024;
  for (int it = blockIdx.x; it < 1024; it += gridDim.x) {
    const int c = it >> 2, j = (it & 3) * 256 + threadIdx.x;
    int first, last, b; bool smp = c >= 128;
    if (smp) { b = (c - 128) >> 6; first = 128 + b * 64; last = first + 63; } else { b = c >> 2; first = b * 4; last = first + 3; }
    float hf = smp ? IN(I_ST_LRU)[(b * 2 + 0) * 1024 + j] : 0.f;
    for (int cc = first; cc < c; ++cc) hf = P[cc * 1024 + j] * hf + H[cc * 1024 + j];
    float hb = smp ? IN(I_ST_LRU)[(b * 2 + 1) * 1024 + j] : 0.f;
    for (int cc = last; cc > c; --cc) hb = P[(256 + cc) * 1024 + j] * hb + H[(256 + cc) * 1024 + j];
    const size_t base = (size_t)(c * 64) * 1024 + j;
    const size_t dstr = (size_t)16384 * 1024;
#pragma unroll 8
    for (int t = 0; t < 64; ++t) {
      hf = __expf(bf2f(la[base + t * 1024])) * hf + bf2f(uu[base + t * 1024]);
      hfs[t * 256 + threadIdx.x] = hf;
    }
    if (!smp && c == last) p.out[O_LRU + (b * 2 + 0) * 1024 + j] = hf;
#pragma unroll 8
    for (int t = 63; t >= 0; --t) {
      hb = __expf(bf2f(la[dstr + base + t * 1024])) * hb + bf2f(uu[dstr + base + t * 1024]);
      const float y = (hfs[t * 256 + threadIdx.x] + hb) * bf2f(ob[base + t * 1024]);
      ob[base + t * 1024] = f2bf(y);
    }
    if (!smp && c == first) p.out[O_LRU + (b * 2 + 1) * 1024 + j] = hb;
  }
}

DI void mla_prenorm(const Params& p) {
  const int lane = threadIdx.x & 63;
  const int gw = blockIdx.x * 4 + (threadIdx.x >> 6), nw = gridDim.x * 4;
  const float* ssk = WSP(const float, S_SS_CKV);
  const float* ssq = WSP(const float, S_SS_CQ);
  u16* ca = WSP(u16, A_CKVA);
  u16* cq = WSP(u16, A_CQ);
  float* oc = p.out + O_MLA_CKV;
  for (int row = gw; row < 16896; row += nw) {
    const float rs = rsqrtf((ssk[row] + ssk[16896 + row]) * (1.f / 256.f) + EPS);
    uint2 v = *(uint2*)(ca + (size_t)row * 256 + lane * 4);
    v.x = pack2(bflo(v.x) * rs, bfhi(v.x) * rs); v.y = pack2(bflo(v.y) * rs, bfhi(v.y) * rs);
    *(uint2*)(ca + (size_t)row * 256 + lane * 4) = v;
    if (row < 8192) {
      float4 o = *(float4*)(oc + (size_t)row * 256 + lane * 4);
      o.x *= rs; o.y *= rs; o.z *= rs; o.w *= rs;
      *(float4*)(oc + (size_t)row * 256 + lane * 4) = o;
    }
  }
  for (int T = gw; T < 16384; T += nw) {
    const float rs = rsqrtf((ssq[T] + ssq[16384 + T] + ssq[32768 + T]) * (1.f / 384.f) + EPS);
#pragma unroll
    for (int i = 0; i < 3; ++i) {
      u32* q = (u32*)(cq + (size_t)T * 384) + lane + 64 * i;
      const u32 v = *q;
      *q = pack2(bflo(v) * rs, bfhi(v) * rs);
    }
  }
}

DI void phase_release() {
  asm volatile("s_waitcnt vmcnt(0)" ::: "memory");
  __syncthreads();
  if (threadIdx.x == 0) { __builtin_amdgcn_fence(__ATOMIC_RELEASE, "agent"); asm volatile("s_waitcnt vmcnt(0)" ::: "memory"); }
  __syncthreads();
}
DI void phase_acquire() {
  if (threadIdx.x == 0) { __builtin_amdgcn_fence(__ATOMIC_ACQUIRE, "agent"); asm volatile("s_waitcnt vmcnt(0)" ::: "memory"); }
  __syncthreads();
}
constexpr int N_PHASES = 27;

__global__ void __launch_bounds__(256, 2) mega(KArgs ka) {
  extern __shared__ __attribute__((aligned(16))) char smem[];
  cg::grid_group grid = cg::this_grid();
  if (threadIdx.x < N_IN) ((const float**)(smem + SMEM_TAB))[threadIdx.x] = ka.in[threadIdx.x];
  __syncthreads();
  Params p; p.tab = smem + SMEM_TAB; p.out = ka.out; p.ws = ka.ws;
  const int ph0 = ka.ph0, ph1 = ka.ph1;
#define PH(k, ...)                                  \
  if ((k) >= ph0 && (k) < ph1) { __VA_ARGS__; }     \
  if ((k) >= ph0 && (k) + 1 < ph1) { asm volatile("s_waitcnt vmcnt(0)" ::: "memory"); grid.sync(); }
#define FFN_PHASES(k, l)                                                                                                                        \
  PH(k, gemm_phase<E_FFN_IN>(p, l, WSP(const u16, A_XG), 1024, WSP(const u16, W_FFN_IN) + (size_t)(l) * 5632 * 1024, 1024, 1024, 128, 44, smem)) \
  PH((k) + 1, gemm_phase<E_RES_FFN>(p, l, WSP(const u16, A_HB), 2816, WSP(const u16, W_FFN_OUT) + (size_t)(l) * 1024 * 2816, 2816, 2816, 128, 8, smem))

  PH(0, phase0(p, smem))
  PH(1, phase1(p))
  PH(2, gemm_phase<E_MLA_IN>(p, 0, WSP(const u16, A_XG), 1024, WSP(const u16, W_MLA_IN), 1024, 1024, 128, 6, smem); cache_prep_mla(p))
  PH(3, mla_prenorm(p))
  PH(4, gemm_phase<E_MLA_Q>(p, 0, WSP(const u16, A_CQ), 384, WSP(const u16, W_MLA_UQ), 384, 384, 128, 12, smem);
        gemm_phase<E_MLA_KV>(p, 0, WSP(const u16, A_CKVA), 256, WSP(const u16, W_MLA_UKV), 256, 256, 132, 16, smem))
  PH(5, attn_phase<192, 1>(p, 1536, 1536, 8, 1, 0.07216878364870323f, 0.f, smem))
  PH(6, gemm_phase<E_RES_MIX>(p, 0, WSP(const u16, A_OB_ATT), 1024, WSP(const u16, W_MLA_O), 1024, 1024, 128, 8, smem))
  FFN_PHASES(7, 0)
  PH(9, gemm_phase<E_DIFF_IN>(p, 1, WSP(const u16, A_XG), 1024, WSP(const u16, W_DIFF_IN), 1024, 1024, 128, 24, smem);
        cache_prep_kv(p, IN(I_CDIFF_K), IN(I_CDIFF_V), 1024, 8))
  PH(10, attn_phase<64, 2>(p, 1024, 1024, 8, 1, 0.125f, 0.3555090675f, smem))
  PH(11, gemm_phase<E_RES_MIX>(p, 1, WSP(const u16, A_OB_ATT), 1024, WSP(const u16, W_DIFF_O), 1024, 1024, 128, 8, smem))
  FFN_PHASES(12, 1)
  PH(14, gemm_phase<E_GQA_IN>(p, 2, WSP(const u16, A_XG), 1024, WSP(const u16, W_GQA_IN), 1024, 1024, 128, 12, smem);
         cache_prep_kv(p, IN(I_CGQA_K), IN(I_CGQA_V), 256, 2))
  PH(15, attn_phase<128, 1>(p, 1024, 256, 2, 4, 0.08838834764831845f, 0.f, smem))
  PH(16, gemm_phase<E_RES_MIX>(p, 2, WSP(const u16, A_OB_ATT), 1024, WSP(const u16, W_GQA_O), 1024, 1024, 128, 8, smem))
  FFN_PHASES(17, 2)
  PH(19, gemm_phase<E_LRU_IN>(p, 3, WSP(const u16, A_XG), 1024, WSP(const u16, W_LRU_IN), 1024, 1024, 128, 16, smem))
  PH(20, lru_conv(p))
  PH(21, gemm_phase<E_GATE>(p, 3, WSP(const u16, A_XR), 1024, WSP(const u16, W_LRU_GATE), 128, 128, 128, 32, smem))
  PH(22, lru_summ(p))
  PH(23, lru_final(p, smem))
  PH(24, gemm_phase<E_RES_MIX>(p, 3, WSP(const u16, A_OB_LRU), 1024, WSP(const u16, W_LRU_OUT), 1024, 1024, 128, 8, smem))
  FFN_PHASES(25, 3)
}

extern "C" void kernel_launch(void* const* d_in, const int* in_sizes, int n_in, void* d_out, int out_size, void* d_ws, size_t ws_size,
                              hipStream_t stream) {
  static int grid_blocks = 0;
  if (!grid_blocks) {
    int dev = 0, cus = 0, per_cu = 0;
    hipGetDevice(&dev);
    hipDeviceGetAttribute(&cus, hipDeviceAttributeMultiprocessorCount, dev);
    hipFuncSetAttribute((const void*)mega, hipFuncAttributeMaxDynamicSharedMemorySize, SMEM_BYTES);
    hipOccupancyMaxActiveBlocksPerMultiprocessor(&per_cu, mega, 256, SMEM_BYTES);
    if (per_cu > 2) per_cu = 2;
    grid_blocks = cus * per_cu;
  }
  if (ws_size < WS_NEED || n_in < N_IN) { fprintf(stderr, "workspace too small: %zu < %zu\n", ws_size, (size_t)WS_NEED); return; }
  KArgs p{};
  for (int i = 0; i < N_IN; ++i) p.in[i] = (const float*)d_in[i];
  p.out = (float*)d_out;
  p.ws = (char*)d_ws;
  p.ph0 = 0; p.ph1 = N_PHASES;
#ifdef MULTI_LAUNCH
  p.ph0 = -1; p.ph1 = 0;
  hipLaunchKernelGGL(mega, dim3(grid_blocks), dim3(256), SMEM_BYTES, stream, p);
  for (int ph = 0; ph < N_PHASES; ++ph) {
    p.ph0 = ph; p.ph1 = ph + 1;
    hipLaunchKernelGGL(mega, dim3(grid_blocks), dim3(256), SMEM_BYTES, stream, p);
  }
#else
  void* args[] = {&p};
  hipError_t e = hipLaunchCooperativeKernel((void*)mega, dim3(grid_blocks), dim3(256), args, SMEM_BYTES, stream);
  if (e != hipSuccess) fprintf(stderr, "cooperative launch failed: %s (grid %d)\n", hipGetErrorString(e), grid_blocks);
#endif
}
```

```cpp
#include <hip/hip_runtime.h>
#include <hip/hip_cooperative_groups.h>
#include <cstdio>
namespace cg = cooperative_groups;

typedef unsigned short u16;
typedef unsigned int u32;
using bf16x8 = __attribute__((ext_vector_type(8))) short;
using f32x16 = __attribute__((ext_vector_type(16))) float;
typedef __bf16 v2bf __attribute__((ext_vector_type(2)));
typedef float v2f __attribute__((ext_vector_type(2)));
typedef unsigned int u32x4 __attribute__((ext_vector_type(4)));
typedef float f32x4v __attribute__((ext_vector_type(4)));
#define GAS __attribute__((address_space(1)))
typedef const float GAS* GF;
#define DI __device__ __forceinline__

enum {
  I_XP, I_XS, I_CMLA_CKV, I_CMLA_KR, I_CDIFF_K, I_CDIFF_V, I_CGQA_K, I_CGQA_V, I_ST_LRU, I_C, I_CCTX,
  I_WMOD, I_BMOD, I_GN1, I_GN2, I_WFFN_IN, I_WFFN_OUT,
  I_MLA_WIN, I_MLA_GCQ, I_MLA_GCKV, I_MLA_WUQ, I_MLA_WUKV, I_MLA_GQK, I_MLA_WO,
  I_DIFF_WIN, I_DIFF_GQK, I_DIFF_LAM, I_DIFF_GSUB, I_DIFF_WO,
  I_GQA_WIN, I_GQA_GQK, I_GQA_WO,
  I_LRU_WIN, I_LRU_CONVW, I_LRU_CONVB, I_LRU_WGATE, I_LRU_BGATE, I_LRU_LAM, I_LRU_WOUT, N_IN
};

struct KArgs {
  const float* in[N_IN];
  float* out;
  char* ws;
  int ph0, ph1;
};
struct Params {
  const char* tab;
  float* out;
  char* ws;
};
constexpr int SMEM_TAB = 73728;
__device__ __forceinline__ const float __attribute__((address_space(1)))* pin_(const char* tab, int i) {
  const unsigned* t = (const unsigned*)tab + 2 * i;
  const unsigned lo = __builtin_amdgcn_readfirstlane(t[0]), hi = __builtin_amdgcn_readfirstlane(t[1]);
  return (const float __attribute__((address_space(1)))*)(((unsigned long long)hi << 32) | lo);
}
#define IN(i) pin_(p.tab, (i))

constexpr int O_Y = 0;
constexpr int O_MLA_CKV = 16777216;
constexpr int O_MLA_KR = O_MLA_CKV + 2097152;
constexpr int O_DIFF_K = O_MLA_KR + 524288;
constexpr int O_DIFF_V = O_DIFF_K + 8388608;
constexpr int O_GQA_K = O_DIFF_V + 8388608;
constexpr int O_GQA_V = O_GQA_K + 2097152;
constexpr int O_LRU = O_GQA_V + 2097152;

constexpr size_t W_MLA_IN = 0;
constexpr size_t W_MLA_UQ = W_MLA_IN + 768 * 1024 * 2;
constexpr size_t W_MLA_UKV = W_MLA_UQ + 1536 * 384 * 2;
constexpr size_t W_MLA_O = W_MLA_UKV + 2048 * 256 * 2;
constexpr size_t W_DIFF_IN = W_MLA_O + 1024 * 1024 * 2;
constexpr size_t W_DIFF_O = W_DIFF_IN + 3072 * 1024 * 2;
constexpr size_t W_GQA_IN = W_DIFF_O + 1024 * 1024 * 2;
constexpr size_t W_GQA_O = W_GQA_IN + 1536 * 1024 * 2;
constexpr size_t W_LRU_IN = W_GQA_O + 1024 * 1024 * 2;
constexpr size_t W_LRU_GATE = W_LRU_IN + 2048 * 1024 * 2;
constexpr size_t W_LRU_OUT = W_LRU_GATE + 4096 * 128 * 2;
constexpr size_t W_FFN_IN = W_LRU_OUT + 1024 * 1024 * 2;
constexpr size_t W_FFN_OUT = W_FFN_IN + (size_t)4 * 5632 * 1024 * 2;
constexpr size_t S_MOD = W_FFN_OUT + (size_t)4 * 1024 * 2816 * 2;
constexpr size_t S_SHW_MIX = S_MOD + 4 * 3 * 6144 * 4;
constexpr size_t S_SHW_FFN = S_SHW_MIX + 4 * 3 * 3072 * 4;
constexpr size_t S_ROWSS = S_SHW_FFN + 4 * 3 * 5632 * 4;
constexpr size_t S_SS_CQ = S_ROWSS + (size_t)8 * 8 * 16384 * 4;
constexpr size_t S_SS_CKV = S_SS_CQ + 3 * 16384 * 4;
constexpr size_t S_ROPE64 = S_SS_CKV + 2 * 16896 * 4;
constexpr size_t S_ROPE128 = S_ROPE64 + 4096 * 32 * 8;
constexpr size_t S_SUMM = S_ROPE128 + 4096 * 64 * 8;
constexpr size_t A_XG = S_SUMM + 2 * 2 * 256 * 1024 * 4;
constexpr size_t A_HB = A_XG + (size_t)16384 * 1024 * 2;
constexpr size_t A_QB = A_HB;
constexpr size_t A_OB_ATT = A_HB + (size_t)16384 * 1536 * 2;
constexpr size_t A_GG = A_HB;
constexpr size_t A_XR = A_HB + (size_t)16384 * 1024 * 2;
constexpr size_t A_ARENA = A_HB + (size_t)16384 * 2816 * 2;
constexpr size_t A_KB = A_ARENA;
constexpr size_t A_VT = A_KB + (size_t)16896 * 1536 * 2;
constexpr size_t A_CQ = A_VT + (size_t)8 * 128 * 16896 * 2;
constexpr size_t A_CKVA = A_CQ + (size_t)16384 * 384 * 2;
constexpr size_t A_ATT_END = A_CKVA + (size_t)16896 * 256 * 2;
constexpr size_t A_OB_LRU = A_ARENA;
constexpr size_t A_LA = A_OB_LRU + (size_t)16384 * 1024 * 2;
constexpr size_t A_U = A_LA + (size_t)2 * 16384 * 1024 * 2;
constexpr size_t A_XRRAW = A_U;
constexpr size_t A_LRU_END = A_U + (size_t)2 * 16384 * 1024 * 2;
constexpr size_t WS_NEED = A_LRU_END > A_ATT_END ? A_LRU_END : A_ATT_END;

constexpr int SMEM_BYTES = 73728 + 512;
constexpr float EPS = 1e-6f;

DI u32 pack2(float a, float b) { v2f v = {a, b}; v2bf r = __builtin_convertvector(v, v2bf); return __builtin_bit_cast(u32, r); }
DI u16 f2bf(float a) { return (u16)(pack2(a, 0.f) & 0xffffu); }
DI float bf2f(u16 v) { return __uint_as_float(((u32)v) << 16); }
DI float bflo(u32 v) { return __uint_as_float(v << 16); }
DI float bfhi(u32 v) { return __uint_as_float(v & 0xffff0000u); }
DI float hsum32(float v) {
  v += __shfl_xor(v, 1); v += __shfl_xor(v, 2); v += __shfl_xor(v, 4); v += __shfl_xor(v, 8); v += __shfl_xor(v, 16);
  return v;
}
DI float wsum64(float v) { v = hsum32(v); v += __shfl_xor(v, 32); return v; }
DI float sigmoidf_(float x) { return __builtin_amdgcn_rcpf(1.f + __expf(-x)); }
DI float siluf_(float x) { return x * __builtin_amdgcn_rcpf(1.f + __expf(-x)); }
DI float geluf_(float x) { const float u = 1.5957691216057308f * (x + 0.044715f * x * x * x); return x * __builtin_amdgcn_rcpf(1.f + __expf(-u)); }

template <int NP> DI float ss_sum(const float* base, int stride, int row) {
  float v[NP];
#pragma unroll
  for (int i = 0; i < NP; ++i) v[i] = base[i * stride + row];
  if (NP == 8) return ((v[0] + v[1]) + (v[2] + v[3])) + ((v[4] + v[5]) + (v[6] + v[7]));
  float s = v[0];
#pragma unroll
  for (int i = 1; i < NP; ++i) s += v[i];
  return s;
}
struct TileInfo { int T0, cr, pos0, kr0, b; bool smp; };
DI TileInfo tile_info(int mt) {
  TileInfo t; t.T0 = mt * 128; t.smp = t.T0 >= 8192;
  if (t.smp) { int u = t.T0 - 8192; t.b = u >> 12; t.pos0 = u & 4095; t.cr = 1 + t.b; t.kr0 = 8192 + t.b * 4352 + 256 + t.pos0; }
  else { t.b = t.T0 >> 8; t.pos0 = t.T0 & 255; t.cr = 0; t.kr0 = t.T0; }
  return t;
}
DI int vt_off(bool smp, int b, int HKV, int vh, int dv, int key) {
  return smp ? 32 * HKV * 128 * 256 + ((b * HKV + vh) * 128 + dv) * 4352 + key : ((b * HKV + vh) * 128 + dv) * 256 + key;
}

#define WSP(T, off) ((T*)(p.ws + (off)))
#define MODP(l, cr, i) (WSP(const float, S_MOD) + ((l) * 3 + (cr)) * 6144 + (i) * 1024)

enum { E_MLA_IN, E_MLA_Q, E_MLA_KV, E_RES_MIX, E_RES_FFN, E_FFN_IN, E_DIFF_IN, E_GQA_IN, E_LRU_IN, E_GATE };

DI void vt_store4(u16* vt, int off, float a, float b, float c, float d) {
  uint2 v; v.x = pack2(a, b); v.y = pack2(c, d); *(uint2*)(vt + off) = v;
}

template <int E>
DI void epilogue(const Params& p, int l, int mt, int nt, f32x16 (&acc)[4]) {
  const int lane = threadIdx.x & 63, w = threadIdx.x >> 6, l32 = lane & 31, hh = lane >> 5;
  const int rbase = w * 32 + 4 * hh;
#define ROWL(r) (rbase + 8 * ((r) >> 2) + ((r) & 3))

  if constexpr (E == E_RES_MIX || E == E_RES_FFN) {
    const TileInfo ti = tile_info(mt);
    float* x = p.out;
    const float* gate = MODP(l, ti.cr, E == E_RES_MIX ? 2 : 5);
    const bool has_next = (E == E_RES_MIX) || (l < 3);
    GF gn = (E == E_RES_MIX) ? IN(I_GN2) + l * 1024 : IN(I_GN1) + (l + 1) * 1024;
    const float* sc = (E == E_RES_MIX) ? MODP(l, ti.cr, 4) : MODP(l + 1, ti.cr, 1);
    float* ssn = WSP(float, S_ROWSS) + (((E == E_RES_MIX) ? 2 * l + 1 : 2 * l + 2) * 8 + nt) * 16384;
    u16* xg = WSP(u16, A_XG);
    float sq[16];
#pragma unroll
    for (int r = 0; r < 16; ++r) sq[r] = 0.f;
#pragma unroll
    for (int nb = 0; nb < 4; ++nb) {
      const int col = nt * 128 + nb * 32 + l32;
      const float gt = gate[col];
      const float gs = has_next ? gn[col] * (1.f + sc[col]) : 0.f;
#pragma unroll
      for (int r = 0; r < 16; ++r) {
        const int T = ti.T0 + ROWL(r);
        const float xn = x[T * 1024 + col] + gt * acc[nb][r];
        x[T * 1024 + col] = xn;
        if (has_next) { xg[T * 1024 + col] = f2bf(xn * gs); sq[r] += xn * xn; }
      }
    }
    if (has_next) {
#pragma unroll
      for (int r = 0; r < 16; ++r) { float s = hsum32(sq[r]); if (l32 == 0) ssn[ti.T0 + ROWL(r)] = s; }
    }
    return;
  }

  if constexpr (E == E_MLA_Q) {
    const TileInfo ti = tile_info(mt);
    GF g = IN(I_MLA_GQK);
    u16* qb = WSP(u16, A_QB);
    if (nt < 8) {
      float sq[16];
#pragma unroll
      for (int r = 0; r < 16; ++r) {
        float s = 0.f;
#pragma unroll
        for (int nb = 0; nb < 4; ++nb) { s += acc[nb][r] * acc[nb][r]; }
        sq[r] = rsqrtf(hsum32(s) * (1.f / 128.f) + EPS);
      }
#pragma unroll
      for (int nb = 0; nb < 4; ++nb) {
        const int c = nb * 32 + l32; const float gg = g[c];
#pragma unroll
        for (int r = 0; r < 16; ++r) qb[(ti.T0 + ROWL(r)) * 1536 + nt * 192 + c] = f2bf(acc[nb][r] * sq[r] * gg);
      }
    } else {
      const float2* rt = WSP(const float2, S_ROPE64);
#pragma unroll
      for (int pr = 0; pr < 2; ++pr) {
        const int h = (nt - 8) * 2 + pr;
        const float g1 = g[128 + l32], g2 = g[160 + l32];
#pragma unroll
        for (int r = 0; r < 16; ++r) {
          float a = acc[2 * pr][r], b = acc[2 * pr + 1][r];
          float n = rsqrtf(hsum32(a * a + b * b) * (1.f / 64.f) + EPS);
          a *= n * g1; b *= n * g2;
          const int T = ti.T0 + ROWL(r);
          if (ti.smp) { float2 cs = rt[(ti.pos0 + ROWL(r)) * 32 + l32]; float a2 = a * cs.x - b * cs.y; b = a * cs.y + b * cs.x; a = a2; }
          qb[T * 1536 + h * 192 + 128 + l32] = f2bf(a);
          qb[T * 1536 + h * 192 + 160 + l32] = f2bf(b);
        }
      }
    }
    return;
  }

  if constexpr (E == E_MLA_KV) {
    const int kr0 = mt * 128;
    const int h = nt >> 1;
    if ((nt & 1) == 0) {
      GF g = IN(I_MLA_GQK) + 192;
      u16* kb = WSP(u16, A_KB);
      float gg[4];
#pragma unroll
      for (int nb = 0; nb < 4; ++nb) gg[nb] = g[nb * 32 + l32];
#pragma unroll
      for (int r = 0; r < 16; ++r) {
        const float t0 = acc[0][r], t1 = acc[1][r], t2 = acc[2][r], t3 = acc[3][r];
        const float n = rsqrtf(hsum32(t0 * t0 + t1 * t1 + t2 * t2 + t3 * t3) * (1.f / 128.f) + EPS);
        u16* d = kb + (kr0 + ROWL(r)) * 1536 + h * 192 + l32;
        d[0] = f2bf(t0 * n * gg[0]); d[32] = f2bf(t1 * n * gg[1]); d[64] = f2bf(t2 * n * gg[2]); d[96] = f2bf(t3 * n * gg[3]);
      }
    } else {
      u16* vt = WSP(u16, A_VT);
      const bool smp = kr0 >= 8192;
      int b, key0;
      if (smp) { int u = kr0 - 8192; b = u / 4352; key0 = u - b * 4352; } else { b = kr0 >> 8; key0 = kr0 & 255; }
#pragma unroll
      for (int nb = 0; nb < 4; ++nb) {
        const int dv = nb * 32 + l32;
#pragma unroll
        for (int g4 = 0; g4 < 4; ++g4) {
          const int off = vt_off(smp, b, 8, h, dv, key0 + rbase + 8 * g4);
          vt_store4(vt, off, acc[nb][4 * g4], acc[nb][4 * g4 + 1], acc[nb][4 * g4 + 2], acc[nb][4 * g4 + 3]);
        }
      }
    }
    return;
  }

  if constexpr (E == E_GATE) {
    const TileInfo ti = tile_info(mt);
    const int d = nt >> 4, blk = (nt >> 1) & 7, half = nt & 1;
    GF bg = IN(I_LRU_BGATE) + d * 2048;
    GF lam = IN(I_LRU_LAM) + d * 1024;
    const u16* xr = WSP(const u16, A_XR);
    u16* la = WSP(u16, A_LA) + (size_t)d * 16384 * 1024;
    u16* uu = WSP(u16, A_U) + (size_t)d * 16384 * 1024;
    const int j0 = blk * 128 + half * 64 + l32;
    const float br0 = bg[j0], bi0 = bg[1024 + j0], br1 = bg[j0 + 32], bi1 = bg[1024 + j0 + 32];
    const float sp0 = -8.f * log1pf(__expf(-lam[j0])), sp1 = -8.f * log1pf(__expf(-lam[j0 + 32]));
#pragma unroll
    for (int r = 0; r < 16; ++r) {
      const int o = (ti.T0 + ROWL(r)) * 1024 + j0;
      const u32 xv0 = xr[o], xv1 = xr[o + 32];
      const float la0 = sigmoidf_(acc[0][r] + br0) * sp0, la1 = sigmoidf_(acc[1][r] + br1) * sp1;
      const float u0 = sqrtf(fmaxf(1.f - __expf(2.f * la0), 0.f)) * sigmoidf_(acc[2][r] + bi0) * bf2f((u16)xv0);
      const float u1 = sqrtf(fmaxf(1.f - __expf(2.f * la1), 0.f)) * sigmoidf_(acc[3][r] + bi1) * bf2f((u16)xv1);
      la[o] = f2bf(la0); la[o + 32] = f2bf(la1);
      uu[o] = f2bf(u0); uu[o + 32] = f2bf(u1);
      if ((r & 3) == 3) __builtin_amdgcn_sched_barrier(0);
    }
    return;
  }

  if constexpr (E == E_MLA_IN || E == E_FFN_IN || E == E_DIFF_IN || E == E_GQA_IN || E == E_LRU_IN) {
    const TileInfo ti = tile_info(mt);
    const int slot = (E == E_FFN_IN) ? 2 * l + 1 : 2 * l;
    const int NW = (E == E_FFN_IN) ? 5632 : 3072;
    const float* ss = WSP(const float, S_ROWSS) + slot * 8 * 16384;
    const float* shw = ((E == E_FFN_IN) ? WSP(const float, S_SHW_FFN) + l * 3 * 5632 : WSP(const float, S_SHW_MIX) + l * 3 * 3072) + ti.cr * NW;
    float rs[16];
#pragma unroll
    for (int r = 0; r < 16; ++r) rs[r] = ss_sum<8>(ss, 16384, ti.T0 + ROWL(r));
#pragma unroll
    for (int r = 0; r < 16; ++r) rs[r] = rsqrtf(rs[r] * (1.f / 1024.f) + EPS);
#pragma unroll
    for (int nb = 0; nb < 4; ++nb) {
      const float bias = shw[nt * 128 + nb * 32 + l32];
#pragma unroll
      for (int r = 0; r < 16; ++r) acc[nb][r] = acc[nb][r] * rs[r] + bias;
    }

    if constexpr (E == E_FFN_IN) {
      u16* hb = WSP(u16, A_HB);
#pragma unroll
      for (int nbp = 0; nbp < 2; ++nbp) {
        const int hc = nt * 64 + nbp * 32 + l32;
#pragma unroll
        for (int r = 0; r < 16; ++r) hb[(size_t)(ti.T0 + ROWL(r)) * 2816 + hc] = f2bf(siluf_(acc[nbp][r]) * acc[nbp + 2][r]);
      }
    }

    if constexpr (E == E_LRU_IN) {
      if (nt < 8) {
        u16* gg = WSP(u16, A_OB_LRU);
#pragma unroll
        for (int nb = 0; nb < 4; ++nb)
#pragma unroll
          for (int r = 0; r < 16; ++r) { gg[(ti.T0 + ROWL(r)) * 1024 + nt * 128 + nb * 32 + l32] = f2bf(geluf_(acc[nb][r])); }
      } else {
        u16* xw = WSP(u16, A_XRRAW);
#pragma unroll
        for (int nb = 0; nb < 4; ++nb)
#pragma unroll
          for (int r = 0; r < 16; ++r) xw[(ti.T0 + ROWL(r)) * 1024 + (nt - 8) * 128 + nb * 32 + l32] = f2bf(acc[nb][r]);
      }
    }

    if constexpr (E == E_MLA_IN) {
      if (nt < 3) {
        GF g = IN(I_MLA_GCQ);
        u16* cq = WSP(u16, A_CQ);
        float* sscq = WSP(float, S_SS_CQ);
        float sq[16];
#pragma unroll
        for (int r = 0; r < 16; ++r) sq[r] = 0.f;
#pragma unroll
        for (int nb = 0; nb < 4; ++nb) {
          const int c = nt * 128 + nb * 32 + l32; const float gg = g[c];
#pragma unroll
          for (int r = 0; r < 16; ++r) { const float v = acc[nb][r]; sq[r] += v * v; cq[(ti.T0 + ROWL(r)) * 384 + c] = f2bf(v * gg); }
        }
#pragma unroll
        for (int r = 0; r < 16; ++r) { float s = hsum32(sq[r]); if (l32 == 0) sscq[nt * 16384 + ti.T0 + ROWL(r)] = s; }
      } else if (nt < 5) {
        GF g = IN(I_MLA_GCKV);
        u16* ca = WSP(u16, A_CKVA);
        float* ssk = WSP(float, S_SS_CKV);
        float* oc = p.out + O_MLA_CKV;
        float sq[16];
#pragma unroll
        for (int r = 0; r < 16; ++r) sq[r] = 0.f;
#pragma unroll
        for (int nb = 0; nb < 4; ++nb) {
          const int c = (nt - 3) * 128 + nb * 32 + l32; const float gg = g[c];
#pragma unroll
          for (int r = 0; r < 16; ++r) {
            const float v = acc[nb][r]; sq[r] += v * v;
            ca[(ti.kr0 + ROWL(r)) * 256 + c] = f2bf(v * gg);
            if (!ti.smp) oc[(ti.T0 + ROWL(r)) * 256 + c] = v * gg;
          }
        }
#pragma unroll
        for (int r = 0; r < 16; ++r) { float s = hsum32(sq[r]); if (l32 == 0) ssk[(nt - 3) * 16896 + ti.kr0 + ROWL(r)] = s; }
      } else {
        GF g = IN(I_MLA_GQK) + 192 + 128;
        const float g1 = g[l32], g2 = g[32 + l32];
        const float2* rt = WSP(const float2, S_ROPE64);
        u16* kb = WSP(u16, A_KB);
        float* okr = p.out + O_MLA_KR;
#pragma unroll
        for (int r = 0; r < 16; ++r) {
          float a = acc[0][r], b = acc[1][r];
          const float n = rsqrtf(hsum32(a * a + b * b) * (1.f / 64.f) + EPS);
          a *= n * g1; b *= n * g2;
          const int rl = ROWL(r);
          if (!ti.smp) { okr[(ti.T0 + rl) * 64 + l32] = a; okr[(ti.T0 + rl) * 64 + 32 + l32] = b; }
          else { float2 cs = rt[(ti.pos0 + rl) * 32 + l32]; float a2 = a * cs.x - b * cs.y; b = a * cs.y + b * cs.x; a = a2; }
          const u16 ua = f2bf(a), ub = f2bf(b);
#pragma unroll
          for (int h = 0; h < 8; ++h) { kb[(ti.kr0 + rl) * 1536 + h * 192 + 128 + l32] = ua; kb[(ti.kr0 + rl) * 1536 + h * 192 + 160 + l32] = ub; }
        }
      }
    }

    if constexpr (E == E_DIFF_IN) {
      const int sec = nt >> 3, h = nt & 7;
      if (sec < 2) {
        GF g = IN(I_DIFF_GQK) + sec * 64;
        const float g1 = g[l32], g2 = g[32 + l32];
        const float2* rt = WSP(const float2, S_ROPE64);
        u16* dst = sec == 0 ? WSP(u16, A_QB) : WSP(u16, A_KB);
        const int row0 = sec == 0 ? ti.T0 : ti.kr0;
        float* ok = p.out + O_DIFF_K;
#pragma unroll
        for (int pr = 0; pr < 2; ++pr) {
#pragma unroll
          for (int r = 0; r < 16; ++r) {
            float a = acc[2 * pr][r], b = acc[2 * pr + 1][r];
            const float n = rsqrtf(hsum32(a * a + b * b) * (1.f / 64.f) + EPS);
            a *= n * g1; b *= n * g2;
            const int rl = ROWL(r);
            const int c = h * 128 + pr * 64 + l32;
            if (sec == 1 && !ti.smp) { ok[(ti.T0 + rl) * 1024 + c] = a; ok[(ti.T0 + rl) * 1024 + c + 32] = b; }
            if (ti.smp) { float2 cs = rt[(ti.pos0 + rl) * 32 + l32]; float a2 = a * cs.x - b * cs.y; b = a * cs.y + b * cs.x; a = a2; }
            dst[(row0 + rl) * 1024 + c] = f2bf(a);
            dst[(row0 + rl) * 1024 + c + 32] = f2bf(b);
          }
        }
      } else {
        u16* vt = WSP(u16, A_VT);
        float* ov = p.out + O_DIFF_V;
#pragma unroll
        for (int nb = 0; nb < 4; ++nb) {
          const int dv = nb * 32 + l32;
#pragma unroll
          for (int g4 = 0; g4 < 4; ++g4) {
            const int key = (ti.smp ? 256 : 0) + ti.pos0 + rbase + 8 * g4;
            vt_store4(vt, vt_off(ti.smp, ti.b, 8, h, dv, key), acc[nb][4 * g4], acc[nb][4 * g4 + 1], acc[nb][4 * g4 + 2], acc[nb][4 * g4 + 3]);
          }
          if (!ti.smp) {
#pragma unroll
            for (int r = 0; r < 16; ++r) ov[(ti.T0 + ROWL(r)) * 1024 + h * 128 + dv] = acc[nb][r];
          }
        }
      }
    }

    if constexpr (E == E_GQA_IN) {
      if (nt < 10) {
        const bool isq = nt < 8;
        const int h = isq ? nt : nt - 8;
        GF g = IN(I_GQA_GQK) + (isq ? 0 : 128);
        const float2* rt = WSP(const float2, S_ROPE128);
        u16* dst = isq ? WSP(u16, A_QB) : WSP(u16, A_KB);
        const int ld = isq ? 1024 : 256;
        const int row0 = isq ? ti.T0 : ti.kr0;
        float* ok = p.out + O_GQA_K;
        float gg[4];
#pragma unroll
        for (int nb = 0; nb < 4; ++nb) gg[nb] = g[nb * 32 + l32];
#pragma unroll
        for (int r = 0; r < 16; ++r) {
          float v0 = acc[0][r], v1 = acc[1][r], v2 = acc[2][r], v3 = acc[3][r];
          const float n = rsqrtf(hsum32(v0 * v0 + v1 * v1 + v2 * v2 + v3 * v3) * (1.f / 128.f) + EPS);
          v0 *= n * gg[0]; v1 *= n * gg[1]; v2 *= n * gg[2]; v3 *= n * gg[3];
          const int rl = ROWL(r);
          if (!isq && !ti.smp) {
            float* o = ok + (ti.T0 + rl) * 256 + h * 128 + l32;
            o[0] = v0; o[32] = v1; o[64] = v2; o[96] = v3;
          }
          if (ti.smp) {
            const float2 c0 = rt[(ti.pos0 + rl) * 64 + l32], c1 = rt[(ti.pos0 + rl) * 64 + 32 + l32];
            const float a0 = v0 * c0.x - v2 * c0.y, b0 = v0 * c0.y + v2 * c0.x;
            const float a1 = v1 * c1.x - v3 * c1.y, b1 = v1 * c1.y + v3 * c1.x;
            v0 = a0; v2 = b0; v1 = a1; v3 = b1;
          }
          u16* d = dst + (row0 + rl) * ld + h * 128 + l32;
          d[0] = f2bf(v0); d[32] = f2bf(v1); d[64] = f2bf(v2); d[96] = f2bf(v3);
        }
      } else {
        const int h = nt - 10;
        u16* vt = WSP(u16, A_VT);
        float* ov = p.out + O_GQA_V;
#pragma unroll
        for (int nb = 0; nb < 4; ++nb) {
          const int dv = nb * 32 + l32;
#pragma unroll
          for (int g4 = 0; g4 < 4; ++g4) {
            const int key = (ti.smp ? 256 : 0) + ti.pos0 + rbase + 8 * g4;
            vt_store4(vt, vt_off(ti.smp, ti.b, 2, h, dv, key), acc[nb][4 * g4], acc[nb][4 * g4 + 1], acc[nb][4 * g4 + 2], acc[nb][4 * g4 + 3]);
          }
          if (!ti.smp) {
#pragma unroll
            for (int r = 0; r < 16; ++r) ov[(ti.T0 + ROWL(r)) * 256 + h * 128 + dv] = acc[nb][r];
          }
        }
      }
    }
    return;
  }
#undef ROWL
}

template <int E>
DI void gemm_phase(const Params& p, int l, const u16* A, int lda, const u16* Bt, int ldb, int K, int mtiles, int ntiles, char* smem,
                   int bstart = 0, int nblk = 0) {
  const int tid = threadIdx.x, lane = tid & 63, w = tid >> 6, l32 = lane & 31, hh = lane >> 5;
  u16* sm = (u16*)smem;
  const int total = mtiles * ntiles;
  const int nk = K >> 6;
  const int lrow = tid >> 3, lc8 = (tid & 7) * 8;
  if (nblk == 0) nblk = gridDim.x;
  int bid = (int)blockIdx.x - bstart; if (bid < 0) bid += gridDim.x;
  for (int t = bid; t < total; t += nblk) {
    const int g = t / (8 * ntiles); const int rem = t - g * 8 * ntiles; const int gsz = min(8, mtiles - g * 8);
    const int mt = g * 8 + rem % gsz, nt = rem / gsz;
    const int akoff = (E == E_GATE) ? ((nt >> 1) & 7) * 128 : 0;
    const char* Au = (const char*)(A + (size_t)(mt * 128) * lda + akoff);
    const char* Bu = (const char*)(Bt + (size_t)(nt * 128) * ldb);
    const u32 avo = (u32)((lrow * lda + lc8) * 2), bvo = (u32)((lrow * ldb + lc8) * 2);
    const int swz = (l32 >> 1) & 7;
    const u32 g_aoff = (u32)((lrow * lda + (((tid & 7) ^ ((lrow >> 1) & 7)) * 8)) * 2);
    const u32 g_boff = (u32)((lrow * ldb + (((tid & 7) ^ ((lrow >> 1) & 7)) * 8)) * 2);
#define G_ISSUE(BUF, KT)                                                                                       \
  _Pragma("unroll") for (int i = 0; i < 4; ++i) {                                                              \
    __builtin_amdgcn_global_load_lds((const unsigned*)(Au + (size_t)i * 32 * lda * 2 + (size_t)(KT) * 128 + g_aoff), \
                                     (unsigned*)((char*)sm + (BUF) * 32768 + tid * 16 + i * 4096), 16, 0, 0);   \
    __builtin_amdgcn_global_load_lds((const unsigned*)(Bu + (size_t)i * 32 * ldb * 2 + (size_t)(KT) * 128 + g_boff), \
                                     (unsigned*)((char*)sm + (BUF) * 32768 + 16384 + tid * 16 + i * 4096), 16, 0, 0); \
  }
#define G_FRAGS(FA, FB, BUF, KS)                                                                               \
  FA = *(const bf16x8*)((const char*)sm + (BUF) * 32768 + (w * 32 + l32) * 128 + ((((KS) * 2 + hh) ^ swz) * 16)); \
  _Pragma("unroll") for (int nb = 0; nb < 4; ++nb)                                                             \
    FB[nb] = *(const bf16x8*)((const char*)sm + (BUF) * 32768 + 16384 + (nb * 32 + l32) * 128 + ((((KS) * 2 + hh) ^ swz) * 16));
#define G_MMA(FA, FB)                                                                                          \
  __builtin_amdgcn_s_setprio(1);                                                                               \
  _Pragma("unroll") for (int nb = 0; nb < 4; ++nb) acc[nb] = __builtin_amdgcn_mfma_f32_32x32x16_bf16(FA, FB[nb], acc[nb], 0, 0, 0); \
  __builtin_amdgcn_s_setprio(0);
#define G_COMPUTE(BUF)                                                                                         \
  {                                                                                                            \
    bf16x8 fa0, fb0[4], fa1, fb1[4];                                                                           \
    G_FRAGS(fa0, fb0, BUF, 0)                                                                                  \
    G_FRAGS(fa1, fb1, BUF, 1)                                                                                  \
    __builtin_amdgcn_sched_barrier(0);                                                                         \
    G_MMA(fa0, fb0)                                                                                            \
    G_FRAGS(fa0, fb0, BUF, 2)                                                                                  \
    __builtin_amdgcn_sched_barrier(0);                                                                         \
    G_MMA(fa1, fb1)                                                                                            \
    G_FRAGS(fa1, fb1, BUF, 3)                                                                                  \
    __builtin_amdgcn_sched_barrier(0);                                                                         \
    G_MMA(fa0, fb0)                                                                                            \
    __builtin_amdgcn_sched_barrier(0);                                                                         \
    G_MMA(fa1, fb1)                                                                                            \
  }
    f32x16 acc[4];
#pragma unroll
    for (int nb = 0; nb < 4; ++nb)
#pragma unroll
      for (int r = 0; r < 16; ++r) acc[nb][r] = 0.f;
    G_ISSUE(0, 0)
    for (int kt = 0; kt < nk; kt += 2) {
      asm volatile("s_waitcnt vmcnt(0)" ::: "memory");
      __syncthreads();
      G_ISSUE(1, kt + 1)
      G_COMPUTE(0)
      asm volatile("s_waitcnt vmcnt(0)" ::: "memory");
      __syncthreads();
      if (kt + 2 < nk) G_ISSUE(0, kt + 2)
      G_COMPUTE(1)
    }
    __syncthreads();
#undef G_ISSUE
#undef G_COMPUTE
#undef G_FRAGS
#undef G_MMA
    epilogue<E>(p, l, mt, nt, acc);
  }
}

template <int DQ, int NSUB>
DI void attn_phase(const Params& p, int ldq, int ldk, int HKV, int KVG, float scale, float lam_init, char* smem) {
  constexpr int LDK = DQ + 8;
  constexpr int NKC = DQ / 8;
  constexpr int KCH = (64 * NKC) / 256;
  constexpr int NQF = DQ / 16;
  const int tid = threadIdx.x, lane = tid & 63, w = tid >> 6, l32 = lane & 31, hh = lane >> 5;
  const u16* Q = WSP(const u16, A_QB);
  const u16* Kb = WSP(const u16, A_KB);
  const u16* Vt = WSP(const u16, A_VT);
  u16* O = WSP(u16, A_OB_ATT);
  u16* sK = (u16*)smem;
  u16* sV = sK + 64 * LDK;
  u32* stash = (u32*)(sV + 128 * 72);
  const float sc2 = scale * 1.4426950408889634f;
  const int perm = (l32 & ~12) | ((l32 & 8) >> 1) | ((l32 & 4) << 1);
  const int NH = 8;
  const int n_s = NH * 2 * 32, n_c = NH * 32 * 2;
  for (int it = blockIdx.x; it < n_s + n_c; it += gridDim.x) {
    bool smp; int b, h, qt;
    if (it < n_s) { smp = true; qt = it & 31; h = (it >> 5) & 7; b = it >> 8; }
    else { int u = it - n_s; smp = false; qt = u & 1; h = (u >> 1) & 7; b = u >> 4; }
    const int T0 = (smp ? 8192 + b * 4096 : b * 256) + qt * 128;
    const int KR0 = smp ? 8192 + b * 4352 : b * 256;
    const int nkeys = smp ? 4352 : 256;
    const int ntile = nkeys >> 6;
    const int vh = h / KVG;
    const u16* vbase = Vt + vt_off(smp, b, HKV, vh, 0, 0);
#pragma unroll 1
    for (int sub = 0; sub < NSUB; ++sub) {
      const int qoff = (DQ == 192) ? h * 192 : (NSUB == 2 ? h * 128 + sub * 64 : h * 128);
      const int koff = (DQ == 192) ? h * 192 : (NSUB == 2 ? h * 128 + sub * 64 : vh * 128);
      bf16x8 qf[NQF];
      {
        const u16* qp = Q + (size_t)(T0 + w * 32 + l32) * ldq + qoff + hh * 8;
#pragma unroll
        for (int kk = 0; kk < NQF; ++kk) qf[kk] = *(const bf16x8*)(qp + kk * 16);
      }
      f32x16 oacc[4];
#pragma unroll
      for (int db = 0; db < 4; ++db)
#pragma unroll
        for (int r = 0; r < 16; ++r) oacc[db][r] = 0.f;
      float mrun = -1e30f, lsum = 0.f;
      u32x4 rk[KCH], rv[4];
      constexpr int NP16 = (DQ >= 128) ? 4 : 0;
      constexpr int NP8 = (DQ == 128) ? 0 : 2;
      constexpr int C8 = (DQ == 192) ? 128 : 0;
      const u32 kvo16 = (u32)(((tid >> 4) * ldk + (tid & 15) * 8) * 2);
      const u32 kvo8 = (u32)(((tid >> 3) * ldk + (tid & 7) * 8 + C8) * 2);
      const u32 vvo = (u32)(((tid >> 3) * nkeys + (tid & 7) * 8) * 2);
      u16* const lk16 = sK + (tid >> 4) * LDK + (tid & 15) * 8;
      u16* const lk8 = sK + (tid >> 3) * LDK + (tid & 7) * 8 + C8;
      u16* const lv = sV + (tid >> 3) * 72 + (tid & 7) * 8;
      const char* kuni = (const char*)(Kb + (size_t)KR0 * ldk + koff);
      const char* vuni = (const char*)vbase;
#define ATT_LOAD(jj)                                                                                              \
  {                                                                                                               \
    const char* ku = kuni + (size_t)(jj) * 64 * ldk * 2;                                                          \
    _Pragma("unroll") for (int i = 0; i < NP16; ++i) rk[i] = *(const u32x4*)(ku + (size_t)i * 16 * ldk * 2 + kvo16); \
    _Pragma("unroll") for (int i = 0; i < NP8; ++i) rk[NP16 + i] = *(const u32x4*)(ku + (size_t)i * 32 * ldk * 2 + kvo8); \
    const char* vu = vuni + (size_t)(jj) * 128;                                                                   \
    _Pragma("unroll") for (int i = 0; i < 4; ++i) rv[i] = *(const u32x4*)(vu + (size_t)i * 32 * nkeys * 2 + vvo);  \
  }
      ATT_LOAD(0)
      for (int j = 0; j < ntile; ++j) {
        __syncthreads();
#pragma unroll
        for (int i = 0; i < NP16; ++i) *(u32x4*)(lk16 + i * 16 * LDK) = rk[i];
#pragma unroll
        for (int i = 0; i < NP8; ++i) *(u32x4*)(lk8 + i * 32 * LDK) = rk[NP16 + i];
#pragma unroll
        for (int i = 0; i < 4; ++i) *(u32x4*)(lv + i * 32 * 72) = rv[i];
        __syncthreads();
        if (j + 1 < ntile) ATT_LOAD(j + 1)
#pragma unroll(DQ == 192 ? 1 : 2)
        for (int mb = 0; mb < 2; ++mb) {
          f32x16 sacc;
#pragma unroll
          for (int r = 0; r < 16; ++r) sacc[r] = 0.f;
#pragma unroll
          for (int kk = 0; kk < NQF; ++kk) {
            const bf16x8 a = *(const bf16x8*)(sK + (mb * 32 + perm) * LDK + kk * 16 + hh * 8);
            sacc = __builtin_amdgcn_mfma_f32_32x32x16_bf16(a, qf[kk], sacc, 0, 0, 0);
          }
          float tmax = sacc[0];
#pragma unroll
          for (int r = 1; r < 16; ++r) tmax = fmaxf(tmax, sacc[r]);
          tmax = fmaxf(tmax, __shfl_xor(tmax, 32)) * sc2;
          if (__any(tmax > mrun)) {
            const float mnew = fmaxf(mrun, tmax);
            const float alpha = __builtin_amdgcn_exp2f(mrun - mnew);
            mrun = mnew;
            lsum *= alpha;
#pragma unroll
            for (int db = 0; db < 4; ++db)
#pragma unroll
              for (int r = 0; r < 16; ++r) oacc[db][r] *= alpha;
          }
          v2f psv = {0.f, 0.f};
          const v2f scv = {sc2, sc2}, mv = {mrun, mrun};
#pragma unroll
          for (int r2 = 0; r2 < 8; ++r2) {
            v2f x = {sacc[2 * r2], sacc[2 * r2 + 1]};
            x = x * scv - mv;
            v2f e = {__builtin_amdgcn_exp2f(x.x), __builtin_amdgcn_exp2f(x.y)};
            sacc[2 * r2] = e.x; sacc[2 * r2 + 1] = e.y;
            psv += e;
          }
          lsum += psv.x + psv.y;
#pragma unroll
          for (int s2 = 0; s2 < 2; ++s2) {
            u32x4 pk;
            pk.x = pack2(sacc[8 * s2 + 0], sacc[8 * s2 + 1]); pk.y = pack2(sacc[8 * s2 + 2], sacc[8 * s2 + 3]);
            pk.z = pack2(sacc[8 * s2 + 4], sacc[8 * s2 + 5]); pk.w = pack2(sacc[8 * s2 + 6], sacc[8 * s2 + 7]);
            const bf16x8 pf = __builtin_bit_cast(bf16x8, pk);
#pragma unroll
            for (int db = 0; db < 4; ++db) {
              const bf16x8 a = *(const bf16x8*)(sV + (db * 32 + l32) * 72 + (2 * mb + s2) * 16 + hh * 8);
              oacc[db] = __builtin_amdgcn_mfma_f32_32x32x16_bf16(a, pf, oacc[db], 0, 0, 0);
            }
          }
        }
      }
      lsum += __shfl_xor(lsum, 32);
      const float inv = 1.f / lsum;
      if (NSUB == 2 && sub == 0) {
#pragma unroll
        for (int db = 0; db < 4; ++db)
#pragma unroll
          for (int r2 = 0; r2 < 8; ++r2) stash[((w * 4 + db) * 8 + r2) * 64 + lane] = pack2(oacc[db][2 * r2] * inv, oacc[db][2 * r2 + 1] * inv);
      } else if (NSUB == 2) {
        float lamf;
        {
          GF lm = IN(I_DIFF_LAM);
          const float a = wsum64(lm[lane] * lm[64 + lane]), b = wsum64(lm[128 + lane] * lm[192 + lane]);
          lamf = (__expf(a) - __expf(b) + lam_init) * inv;
        }
        float s = 0.f;
#pragma unroll
        for (int db = 0; db < 4; ++db) {
#pragma unroll
          for (int r2 = 0; r2 < 8; ++r2) {
            const u32 sv = stash[((w * 4 + db) * 8 + r2) * 64 + lane];
            const float v0 = bflo(sv) - lamf * oacc[db][2 * r2], v1 = bfhi(sv) - lamf * oacc[db][2 * r2 + 1];
            s += v0 * v0 + v1 * v1;
          }
          __builtin_amdgcn_sched_barrier(0);
        }
        s += __shfl_xor(s, 32);
        const float n = rsqrtf(s * (1.f / 128.f) + EPS) * (1.f - lam_init);
        GF gs = IN(I_DIFF_GSUB);
        u16* op = O + (size_t)(T0 + w * 32 + l32) * 1024 + h * 128 + 4 * hh;
#pragma unroll
        for (int db = 0; db < 4; ++db) {
#pragma unroll
          for (int g4 = 0; g4 < 4; ++g4) {
            const f32x4v gv = *(const GAS f32x4v*)(gs + db * 32 + 8 * g4 + 4 * hh);
            const u32 s0 = stash[((w * 4 + db) * 8 + 2 * g4) * 64 + lane], s1 = stash[((w * 4 + db) * 8 + 2 * g4 + 1) * 64 + lane];
            uint2 v;
            v.x = pack2((bflo(s0) - lamf * oacc[db][4 * g4]) * n * gv.x, (bfhi(s0) - lamf * oacc[db][4 * g4 + 1]) * n * gv.y);
            v.y = pack2((bflo(s1) - lamf * oacc[db][4 * g4 + 2]) * n * gv.z, (bfhi(s1) - lamf * oacc[db][4 * g4 + 3]) * n * gv.w);
            *(uint2*)(op + db * 32 + 8 * g4) = v;
          }
          __builtin_amdgcn_sched_barrier(0);
        }
      } else {
#pragma unroll
        for (int db = 0; db < 4; ++db)
#pragma unroll
          for (int r = 0; r < 16; ++r) oacc[db][r] *= inv;
      }
      if (NSUB == 1) {
        u16* op = O + (size_t)(T0 + w * 32 + l32) * 1024 + h * 128 + 4 * hh;
#pragma unroll
        for (int db = 0; db < 4; ++db)
#pragma unroll
          for (int g4 = 0; g4 < 4; ++g4) {
            uint2 v; v.x = pack2(oacc[db][4 * g4], oacc[db][4 * g4 + 1]); v.y = pack2(oacc[db][4 * g4 + 2], oacc[db][4 * g4 + 3]);
            *(uint2*)(op + db * 32 + 8 * g4) = v;
          }
      }
    }
  }
}

template <class F>
DI void convert_T(GF src, u16* dst, int K, int N, F idx, char* smem, int& rot) {
  float* sm = (float*)smem;
  const int tid = threadIdx.x, tx = tid & 63, ty = tid >> 6;
  const int kt = K >> 6, ntl = N >> 6, total = kt * ntl;
  int start = (int)blockIdx.x - (rot % (int)gridDim.x); if (start < 0) start += gridDim.x;
  rot += total;
  for (int t = start; t < total; t += gridDim.x) {
    const int k0 = (t % kt) * 64, n0 = (t / kt) * 64;
    const int ln = (tid & 15) * 4, lk = tid >> 4;
#pragma unroll
    for (int i = 0; i < 4; ++i) {
      const int k = k0 + lk + 16 * i; const int id = idx(k, n0 + ln);
      f32x4v v = {0.f, 0.f, 0.f, 0.f};
      if (id >= 0) v = *(const GAS f32x4v*)(src + id);
      float* d = sm + (lk + 16 * i) * 65 + ln;
      d[0] = v.x; d[1] = v.y; d[2] = v.z; d[3] = v.w;
    }
    __syncthreads();
    const int sk = (tid & 7) * 8, sn = tid >> 3;
#pragma unroll
    for (int i = 0; i < 2; ++i) {
      const int nn = sn + 32 * i;
      u32x4 o;
      o.x = pack2(sm[(sk + 0) * 65 + nn], sm[(sk + 1) * 65 + nn]); o.y = pack2(sm[(sk + 2) * 65 + nn], sm[(sk + 3) * 65 + nn]);
      o.z = pack2(sm[(sk + 4) * 65 + nn], sm[(sk + 5) * 65 + nn]); o.w = pack2(sm[(sk + 6) * 65 + nn], sm[(sk + 7) * 65 + nn]);
      *(u32x4*)(dst + (size_t)(n0 + nn) * K + k0 + sk) = o;
    }
    __syncthreads();
  }
}

DI void phase0(const Params& p, char* smem) {
  const int tid = threadIdx.x;
  const int gtid = blockIdx.x * 256 + tid, gsz = gridDim.x * 256;
  {
    float* sil = (float*)smem;
    float* red = sil + 3072;
    for (int i = tid; i < 3072; i += 256) {
      const int cr = i >> 10, k = i & 1023;
      const float v = cr == 0 ? IN(I_CCTX)[k] : IN(I_C)[(cr - 1) * 1024 + k];
      sil[i] = siluf_(v);
    }
    __syncthreads();
    const int c4 = tid & 15, kg = tid >> 4;
    for (int it = blockIdx.x; it < 384; it += gridDim.x) {
      const int l = it / 96, cg0 = (it % 96) * 64;
      GF wp = IN(I_WMOD) + (size_t)l * 1024 * 6144 + (size_t)(kg * 64) * 6144 + cg0 + c4 * 4;
      float a0[4] = {0, 0, 0, 0}, a1[4] = {0, 0, 0, 0}, a2[4] = {0, 0, 0, 0};
#pragma unroll 8
      for (int k = 0; k < 64; ++k) {
        const f32x4v wv = *(const GAS f32x4v*)(wp + (size_t)k * 6144);
        const float s0 = sil[kg * 64 + k], s1 = sil[1024 + kg * 64 + k], s2 = sil[2048 + kg * 64 + k];
        a0[0] += s0 * wv.x; a0[1] += s0 * wv.y; a0[2] += s0 * wv.z; a0[3] += s0 * wv.w;
        a1[0] += s1 * wv.x; a1[1] += s1 * wv.y; a1[2] += s1 * wv.z; a1[3] += s1 * wv.w;
        a2[0] += s2 * wv.x; a2[1] += s2 * wv.y; a2[2] += s2 * wv.z; a2[3] += s2 * wv.w;
      }
#pragma unroll
      for (int q = 0; q < 4; ++q) { red[(kg * 3 + 0) * 64 + c4 * 4 + q] = a0[q]; red[(kg * 3 + 1) * 64 + c4 * 4 + q] = a1[q]; red[(kg * 3 + 2) * 64 + c4 * 4 + q] = a2[q]; }
      __syncthreads();
      if (tid < 192) {
        const int cr = tid >> 6, c = tid & 63;
        float s = 0.f;
#pragma unroll
        for (int g = 0; g < 16; ++g) s += red[(g * 3 + cr) * 64 + c];
        WSP(float, S_MOD)[(l * 3 + cr) * 6144 + cg0 + c] = s + IN(I_BMOD)[l * 6144 + cg0 + c];
      }
      __syncthreads();
    }
  }
  {
    float* sk = WSP(float, S_SS_CKV);
    for (int i = gtid; i < 512; i += gsz) {
      const int row = 8192 + (i >> 8) * 4352 + (i & 255);
      sk[row] = 256.f * (1.f - EPS); sk[16896 + row] = 0.f;
    }
  }
  {
    float2* r64 = WSP(float2, S_ROPE64);
    for (int i = gtid; i < 4096 * 32; i += gsz) {
      const int pos = i >> 5, j = i & 31;
      const float inv = powf(10000.f, -(float)(j & 15) / 16.f);
      const float ang = (float)(j < 16 ? (pos >> 6) : (pos & 63)) * inv;
      float s, c; sincosf(ang, &s, &c); r64[i] = make_float2(c, s);
    }
    float2* r128 = WSP(float2, S_ROPE128);
    for (int i = gtid; i < 4096 * 64; i += gsz) {
      const int pos = i >> 6, j = i & 63;
      const float inv = powf(10000.f, -(float)(j & 31) / 32.f);
      const float ang = (float)(j < 32 ? (pos >> 6) : (pos & 63)) * inv;
      float s, c; sincosf(ang, &s, &c); r128[i] = make_float2(c, s);
    }
  }
  {
    u16* ca = WSP(u16, A_CKVA);
    GF src = IN(I_CMLA_CKV);
    for (int i = gtid; i < 2 * 256 * 256; i += gsz) {
      const int c = i & 255, s = (i >> 8) & 255, b = i >> 16;
      ca[(8192 + b * 4352 + s) * 256 + c] = f2bf(src[i]);
    }
  }
  int rot = 384;
  convert_T(IN(I_MLA_WIN), WSP(u16, W_MLA_IN), 1024, 768, [](int k, int n) { return n < 704 ? k * 704 + n : -1; }, smem, rot);
  convert_T(IN(I_MLA_WUQ), WSP(u16, W_MLA_UQ), 384, 1536,
            [](int k, int n) { return n < 1024 ? k * 1536 + (n >> 7) * 192 + (n & 127) : k * 1536 + ((n - 1024) >> 6) * 192 + 128 + (n & 63); }, smem, rot);
  convert_T(IN(I_MLA_WUKV), WSP(u16, W_MLA_UKV), 256, 2048, [](int k, int n) { return k * 2048 + n; }, smem, rot);
  convert_T(IN(I_MLA_WO), WSP(u16, W_MLA_O), 1024, 1024, [](int k, int n) { return k * 1024 + n; }, smem, rot);
  convert_T(IN(I_DIFF_WIN), WSP(u16, W_DIFF_IN), 1024, 3072, [](int k, int n) { return k * 3072 + n; }, smem, rot);
  convert_T(IN(I_DIFF_WO), WSP(u16, W_DIFF_O), 1024, 1024, [](int k, int n) { return k * 1024 + n; }, smem, rot);
  convert_T(IN(I_GQA_WIN), WSP(u16, W_GQA_IN), 1024, 1536, [](int k, int n) { return k * 1536 + n; }, smem, rot);
  convert_T(IN(I_GQA_WO), WSP(u16, W_GQA_O), 1024, 1024, [](int k, int n) { return k * 1024 + n; }, smem, rot);
  convert_T(IN(I_LRU_WIN), WSP(u16, W_LRU_IN), 1024, 2048, [](int k, int n) { return k * 2048 + n; }, smem, rot);
  convert_T(IN(I_LRU_WGATE), WSP(u16, W_LRU_GATE), 128, 4096,
            [](int k, int n) {
              const int T = n >> 7, wq = n & 127, g = wq >> 6, jj = (T & 1) * 64 + (wq & 63), blk = (T >> 1) & 7, d = T >> 4;
              return (((d * 2 + g) * 8 + blk) * 128 + k) * 128 + jj;
            }, smem, rot);
  convert_T(IN(I_LRU_WOUT), WSP(u16, W_LRU_OUT), 1024, 1024, [](int k, int n) { return k * 1024 + n; }, smem, rot);
  for (int l = 0; l < 4; ++l) {
    convert_T(IN(I_WFFN_IN) + (size_t)l * 1024 * 5632, WSP(u16, W_FFN_IN) + (size_t)l * 5632 * 1024, 1024, 5632,
              [](int k, int n) { const int T = n >> 7, wq = n & 127; return k * 5632 + (wq >> 6) * 2816 + T * 64 + (wq & 63); }, smem, rot);
    convert_T(IN(I_WFFN_OUT) + (size_t)l * 2816 * 1024, WSP(u16, W_FFN_OUT) + (size_t)l * 1024 * 2816, 2816, 1024,
              [](int k, int n) { return k * 1024 + n; }, smem, rot);
  }
}

DI void shw_one(const Params& p, const u16* Wt, int N, int stride, const float* shift  , float* dst) {
  const int lane = threadIdx.x & 63;
  const int gw = blockIdx.x * 4 + (threadIdx.x >> 6), nw = gridDim.x * 4;
  float s0[16], s1[16], s2[16];
#pragma unroll
  for (int i = 0; i < 16; ++i) { s0[i] = shift[lane * 16 + i]; s1[i] = shift[6144 + lane * 16 + i]; s2[i] = shift[12288 + lane * 16 + i]; }
  for (int n = gw; n < N; n += nw) {
    const uint4 w0 = *(const uint4*)(Wt + (size_t)n * 1024 + lane * 16);
    const uint4 w1 = *(const uint4*)(Wt + (size_t)n * 1024 + lane * 16 + 8);
    const u32 wv[8] = {w0.x, w0.y, w0.z, w0.w, w1.x, w1.y, w1.z, w1.w};
    float a0 = 0.f, a1 = 0.f, a2 = 0.f;
#pragma unroll
    for (int i = 0; i < 8; ++i) {
      const float lo = bflo(wv[i]), hi = bfhi(wv[i]);
      a0 += lo * s0[2 * i] + hi * s0[2 * i + 1]; a1 += lo * s1[2 * i] + hi * s1[2 * i + 1]; a2 += lo * s2[2 * i] + hi * s2[2 * i + 1];
    }
    a0 = wsum64(a0); a1 = wsum64(a1); a2 = wsum64(a2);
    if (lane == 0) { dst[n] = a0; dst[stride + n] = a1; dst[2 * stride + n] = a2; }
  }
}

DI void phase1(const Params& p) {
  const int lane = threadIdx.x & 63;
  const int gw = blockIdx.x * 4 + (threadIdx.x >> 6), nw = gridDim.x * 4;
  for (int T = gw; T < 16384; T += nw) {
    GF xs = T < 8192 ? IN(I_XP) + (size_t)T * 1024 : IN(I_XS) + (size_t)(T - 8192) * 1024;
    const int cr = T < 8192 ? 0 : 1 + ((T - 8192) >> 12);
    const float* sc = MODP(0, cr, 1);
    GF gn = IN(I_GN1);
    float ss = 0.f;
#pragma unroll
    for (int i = 0; i < 4; ++i) {
      const int c = lane * 4 + 256 * i;
      const f32x4v v = *(const GAS f32x4v*)(xs + c);
      const float4 s4 = *(const float4*)(sc + c);
      const f32x4v g4 = *(const GAS f32x4v*)(gn + c);
      ss += v.x * v.x + v.y * v.y + v.z * v.z + v.w * v.w;
      *(f32x4v*)(p.out + (size_t)T * 1024 + c) = v;
      uint2 o; o.x = pack2(v.x * g4.x * (1.f + s4.x), v.y * g4.y * (1.f + s4.y)); o.y = pack2(v.z * g4.z * (1.f + s4.z), v.w * g4.w * (1.f + s4.w));
      *(uint2*)(WSP(u16, A_XG) + (size_t)T * 1024 + c) = o;
    }
    ss = wsum64(ss);
    if (lane < 8) WSP(float, S_ROWSS)[lane * 16384 + T] = lane == 0 ? ss : 0.f;
  }
  shw_one(p, WSP(const u16, W_MLA_IN), 768, 3072, MODP(0, 0, 0), WSP(float, S_SHW_MIX) + 0 * 3 * 3072);
  shw_one(p, WSP(const u16, W_DIFF_IN), 3072, 3072, MODP(1, 0, 0), WSP(float, S_SHW_MIX) + 1 * 3 * 3072);
  shw_one(p, WSP(const u16, W_GQA_IN), 1536, 3072, MODP(2, 0, 0), WSP(float, S_SHW_MIX) + 2 * 3 * 3072);
  shw_one(p, WSP(const u16, W_LRU_IN), 2048, 3072, MODP(3, 0, 0), WSP(float, S_SHW_MIX) + 3 * 3 * 3072);
  for (int l = 0; l < 4; ++l)
    shw_one(p, WSP(const u16, W_FFN_IN) + (size_t)l * 5632 * 1024, 5632, 5632, MODP(l, 0, 3), WSP(float, S_SHW_FFN) + l * 3 * 5632);
}

DI void cache_prep_mla(const Params& p) {
  const int gtid = blockIdx.x * 256 + threadIdx.x, gsz = gridDim.x * 256;
  u16* kb = WSP(u16, A_KB);
  GF src = IN(I_CMLA_KR);
  for (int i = gtid; i < 2 * 256 * 64 * 8; i += gsz) {
    const int j = i & 63, h = (i >> 6) & 7, s = (i >> 9) & 255, b = i >> 17;
    kb[(8192 + b * 4352 + s) * 1536 + h * 192 + 128 + j] = f2bf(src[(b * 256 + s) * 64 + j]);
  }
}
DI void cache_prep_kv(const Params& p, GF ck, GF cv, int ldk, int HKV) {
  const int gtid = blockIdx.x * 256 + threadIdx.x, gsz = gridDim.x * 256;
  u16* kb = WSP(u16, A_KB);
  u16* vt = WSP(u16, A_VT);
  const int nk = 2 * 256 * ldk;
  for (int i = gtid; i < nk; i += gsz) {
    const int c = i % ldk, s = (i / ldk) & 255, b = i / (ldk * 256);
    kb[(8192 + b * 4352 + s) * ldk + c] = f2bf(ck[i]);
  }
  const int nv = 2 * 256 * HKV * 128;
  for (int i = gtid; i < nv; i += gsz) {
    const int dv = i & 127, h = (i >> 7) % HKV, s = (i / (128 * HKV)) & 255, b = i / (128 * HKV * 256);
    vt[vt_off(true, b, HKV, h, dv, s)] = f2bf(cv[i]);
  }
}

DI void lru_conv(const Params& p) {
  const int gtid = blockIdx.x * 256 + threadIdx.x, gsz = gridDim.x * 256;
  const u16* xw = WSP(const u16, A_XRRAW);
  u16* xr = WSP(u16, A_XR);
  GF cw = IN(I_LRU_CONVW);
  GF cb = IN(I_LRU_CONVB);
  for (int i = gtid; i < 16384 * 128; i += gsz) {
    const int T = i >> 7, c0 = (i & 127) * 8;
    int pos, S;
    if (T < 8192) { pos = T & 255; S = 256; } else { pos = (T - 8192) & 4095; S = 4096; }
    float y[8];
#pragma unroll
    for (int q = 0; q < 8; ++q) y[q] = cb[c0 + q];
#pragma unroll
    for (int t = 0; t < 4; ++t) {
      const int pp = pos + t - 1;
      if (pp >= 0 && pp < S) {
        const uint4 v = *(const uint4*)(xw + (size_t)(T + t - 1) * 1024 + c0);
        const f32x4v w0 = *(const GAS f32x4v*)(cw + t * 1024 + c0), w1 = *(const GAS f32x4v*)(cw + t * 1024 + c0 + 4);
        y[0] += bflo(v.x) * w0.x; y[1] += bfhi(v.x) * w0.y; y[2] += bflo(v.y) * w0.z; y[3] += bfhi(v.y) * w0.w;
        y[4] += bflo(v.z) * w1.x; y[5] += bfhi(v.z) * w1.y; y[6] += bflo(v.w) * w1.z; y[7] += bfhi(v.w) * w1.w;
      }
    }
    uint4 o; o.x = pack2(y[0], y[1]); o.y = pack2(y[2], y[3]); o.z = pack2(y[4], y[5]); o.w = pack2(y[6], y[7]);
    *(uint4*)(xr + (size_t)T * 1024 + c0) = o;
  }
}

DI void lru_summ(const Params& p) {
  const u16* la = WSP(const u16, A_LA);
  const u16* uu = WSP(const u16, A_U);
  float* P = WSP(float, S_SUMM);
  float* H = P + 2 * 256 * 1024;
  for (int it = blockIdx.x; it < 1024; it += gridDim.x) {
    const int d = it >> 9, c = (it >> 1) & 255, j = ((it & 1) * 256 + threadIdx.x) * 2;
    const size_t base = (size_t)d * 16384 * 1024 + (size_t)(c * 64) * 1024 + j;
    float h0 = 0.f, h1 = 0.f, s0 = 0.f, s1 = 0.f;
#pragma unroll 8
    for (int t = 0; t < 64; ++t) {
      const int tt = d == 0 ? t : 63 - t;
      const u32 lv = *(const u32*)(la + base + tt * 1024), uv = *(const u32*)(uu + base + tt * 1024);
      const float l0 = bflo(lv), l1 = bfhi(lv);
      h0 = __expf(l0) * h0 + bflo(uv); h1 = __expf(l1) * h1 + bfhi(uv);
      s0 += l0; s1 += l1;
    }
    *(float2*)(P + (d * 256 + c) * 1024 + j) = make_float2(__expf(s0), __expf(s1));
    *(float2*)(H + (d * 256 + c) * 1024 + j) = make_float2(h0, h1);
  }
}

DI void lru_final(const Params& p, char* smem) {
  u32* hfs = (u32*)smem;
  const u16* la = WSP(const u16, A_LA);
  const u16* uu = WSP(const u16, A_U);
  u16* ob = WSP(u16, A_OB_LRU);
  const float* P = WSP(const float, S_SUMM);
  const float* H = P + 2 * 256 * 1024;
  for (int it = blockIdx.x; it < 512; it += gridDim.x) {
    const int c = it >> 1, j = ((it & 1) * 256 + threadIdx.x) * 2;
    int first, last, b; bool smp = c >= 128;
    if (smp) { b = (c - 128) >> 6; first = 128 + b * 64; last = first + 63; } else { b = c >> 2; first = b * 4; last = first + 3; }
    float hf0 = 0.f, hf1 = 0.f, hb0 = 0.f, hb1 = 0.f;
    if (smp) {
      GF st = IN(I_ST_LRU);
      hf0 = st[(b * 2 + 0) * 1024 + j]; hf1 = st[(b * 2 + 0) * 1024 + j + 1];
      hb0 = st[(b * 2 + 1) * 1024 + j]; hb1 = st[(b * 2 + 1) * 1024 + j + 1];
    }
    for (int cc = first; cc < c; ++cc) {
      const float2 pv = *(const float2*)(P + cc * 1024 + j), hv = *(const float2*)(H + cc * 1024 + j);
      hf0 = pv.x * hf0 + hv.x; hf1 = pv.y * hf1 + hv.y;
    }
    for (int cc = last; cc > c; --cc) {
      const float2 pv = *(const float2*)(P + (256 + cc) * 1024 + j), hv = *(const float2*)(H + (256 + cc) * 1024 + j);
      hb0 = pv.x * hb0 + hv.x; hb1 = pv.y * hb1 + hv.y;
    }
    const size_t base = (size_t)(c * 64) * 1024 + j;
    const size_t dstr = (size_t)16384 * 1024;
#pragma unroll 8
    for (int t = 0; t < 64; ++t) {
      const u32 lv = *(const u32*)(la + base + t * 1024), uv = *(const u32*)(uu + base + t * 1024);
      hf0 = __expf(bflo(lv)) * hf0 + bflo(uv); hf1 = __expf(bfhi(lv)) * hf1 + bfhi(uv);
      hfs[t * 256 + threadIdx.x] = pack2(hf0, hf1);
    }
    if (!smp && c == last) *(float2*)(p.out + O_LRU + (b * 2 + 0) * 1024 + j) = make_float2(hf0, hf1);
#pragma unroll 8
    for (int t = 63; t >= 0; --t) {
      const u32 lv = *(const u32*)(la + dstr + base + t * 1024), uv = *(const u32*)(uu + dstr + base + t * 1024);
      hb0 = __expf(bflo(lv)) * hb0 + bflo(uv); hb1 = __expf(bfhi(lv)) * hb1 + bfhi(uv);
      const u32 fv = hfs[t * 256 + threadIdx.x], gv = *(const u32*)(ob + base + t * 1024);
      *(u32*)(ob + base + t * 1024) = pack2((bflo(fv) + hb0) * bflo(gv), (bfhi(fv) + hb1) * bfhi(gv));
    }
    if (!smp && c == first) *(float2*)(p.out + O_LRU + (b * 2 + 1) * 1024 + j) = make_float2(hb0, hb1);
  }
}

DI void mla_prenorm(const Params& p) {
  const int lane = threadIdx.x & 63;
  const int gw = blockIdx.x * 4 + (threadIdx.x >> 6), nw = gridDim.x * 4;
  const float* ssk = WSP(const float, S_SS_CKV);
  const float* ssq = WSP(const float, S_SS_CQ);
  u16* ca = WSP(u16, A_CKVA);
  u16* cq = WSP(u16, A_CQ);
  float* oc = p.out + O_MLA_CKV;
  for (int row = gw; row < 16896; row += nw) {
    const float rs = rsqrtf((ssk[row] + ssk[16896 + row]) * (1.f / 256.f) + EPS);
    uint2 v = *(uint2*)(ca + (size_t)row * 256 + lane * 4);
    v.x = pack2(bflo(v.x) * rs, bfhi(v.x) * rs); v.y = pack2(bflo(v.y) * rs, bfhi(v.y) * rs);
    *(uint2*)(ca + (size_t)row * 256 + lane * 4) = v;
    if (row < 8192) {
      float4 o = *(float4*)(oc + (size_t)row * 256 + lane * 4);
      o.x *= rs; o.y *= rs; o.z *= rs; o.w *= rs;
      *(float4*)(oc + (size_t)row * 256 + lane * 4) = o;
    }
  }
  for (int T = gw; T < 16384; T += nw) {
    const float rs = rsqrtf((ssq[T] + ssq[16384 + T] + ssq[32768 + T]) * (1.f / 384.f) + EPS);
#pragma unroll
    for (int i = 0; i < 3; ++i) {
      u32* q = (u32*)(cq + (size_t)T * 384) + lane + 64 * i;
      const u32 v = *q;
      *q = pack2(bflo(v) * rs, bfhi(v) * rs);
    }
  }
}

DI void phase_release() {
  asm volatile("s_waitcnt vmcnt(0)" ::: "memory");
  __syncthreads();
  if (threadIdx.x == 0) { __builtin_amdgcn_fence(__ATOMIC_RELEASE, "agent"); asm volatile("s_waitcnt vmcnt(0)" ::: "memory"); }
  __syncthreads();
}
DI void phase_acquire() {
  if (threadIdx.x == 0) { __builtin_amdgcn_fence(__ATOMIC_ACQUIRE, "agent"); asm volatile("s_waitcnt vmcnt(0)" ::: "memory"); }
  __syncthreads();
}
constexpr int N_PHASES = 27;

__global__ void __launch_bounds__(256, 2) mega(KArgs ka) {
  extern __shared__ __attribute__((aligned(16))) char smem[];
  cg::grid_group grid = cg::this_grid();
  if (threadIdx.x < N_IN) ((const float**)(smem + SMEM_TAB))[threadIdx.x] = ka.in[threadIdx.x];
  __syncthreads();
  Params p; p.tab = smem + SMEM_TAB; p.out = ka.out; p.ws = ka.ws;
  const int ph0 = ka.ph0, ph1 = ka.ph1;
#define PH(k, ...)                                  \
  if ((k) >= ph0 && (k) < ph1) { __VA_ARGS__; }     \
  if ((k) >= ph0 && (k) + 1 < ph1) { asm volatile("s_waitcnt vmcnt(0)" ::: "memory"); grid.sync(); }
#define FFN_PHASES(k, l)                                                                                                                        \
  PH(k, gemm_phase<E_FFN_IN>(p, l, WSP(const u16, A_XG), 1024, WSP(const u16, W_FFN_IN) + (size_t)(l) * 5632 * 1024, 1024, 1024, 128, 44, smem)) \
  PH((k) + 1, gemm_phase<E_RES_FFN>(p, l, WSP(const u16, A_HB), 2816, WSP(const u16, W_FFN_OUT) + (size_t)(l) * 1024 * 2816, 2816, 2816, 128, 8, smem))

  PH(0, phase0(p, smem))
  PH(1, phase1(p))
  PH(2, gemm_phase<E_MLA_IN>(p, 0, WSP(const u16, A_XG), 1024, WSP(const u16, W_MLA_IN), 1024, 1024, 128, 6, smem); cache_prep_mla(p))
  PH(3, mla_prenorm(p))
  PH(4, gemm_phase<E_MLA_Q>(p, 0, WSP(const u16, A_CQ), 384, WSP(const u16, W_MLA_UQ), 384, 384, 128, 12, smem);
        gemm_phase<E_MLA_KV>(p, 0, WSP(const u16, A_CKVA), 256, WSP(const u16, W_MLA_UKV), 256, 256, 132, 16, smem))
  PH(5, attn_phase<192, 1>(p, 1536, 1536, 8, 1, 0.07216878364870323f, 0.f, smem))
  PH(6, gemm_phase<E_RES_MIX>(p, 0, WSP(const u16, A_OB_ATT), 1024, WSP(const u16, W_MLA_O), 1024, 1024, 128, 8, smem))
  FFN_PHASES(7, 0)
  PH(9, gemm_phase<E_DIFF_IN>(p, 1, WSP(const u16, A_XG), 1024, WSP(const u16, W_DIFF_IN), 1024, 1024, 128, 24, smem);
        cache_prep_kv(p, IN(I_CDIFF_K), IN(I_CDIFF_V), 1024, 8))
  PH(10, attn_phase<64, 2>(p, 1024, 1024, 8, 1, 0.125f, 0.3555090675f, smem))
  PH(11, gemm_phase<E_RES_MIX>(p, 1, WSP(const u16, A_OB_ATT), 1024, WSP(const u16, W_DIFF_O), 1024, 1024, 128, 8, smem))
  FFN_PHASES(12, 1)
  PH(14, gemm_phase<E_GQA_IN>(p, 2, WSP(const u16, A_XG), 1024, WSP(const u16, W_GQA_IN), 1024, 1024, 128, 12, smem);
         cache_prep_kv(p, IN(I_CGQA_K), IN(I_CGQA_V), 256, 2))
  PH(15, attn_phase<128, 1>(p, 1024, 256, 2, 4, 0.08838834764831845f, 0.f, smem))
  PH(16, gemm_phase<E_RES_MIX>(p, 2, WSP(const u16, A_OB_ATT), 1024, WSP(const u16, W_GQA_O), 1024, 1024, 128, 8, smem))
  FFN_PHASES(17, 2)
  PH(19, gemm_phase<E_LRU_IN>(p, 3, WSP(const u16, A_XG), 1024, WSP(const u16, W_LRU_IN), 1024, 1024, 128, 16, smem))
  PH(20, lru_conv(p))
  PH(21, gemm_phase<E_GATE>(p, 3, WSP(const u16, A_XR), 1024, WSP(const u16, W_LRU_GATE), 128, 128, 128, 32, smem))
  PH(22, lru_summ(p))
  PH(23, lru_final(p, smem))
  PH(24, gemm_phase<E_RES_MIX>(p, 3, WSP(const u16, A_OB_LRU), 1024, WSP(const u16, W_LRU_OUT), 1024, 1024, 128, 8, smem))
  FFN_PHASES(25, 3)
}

extern "C" void kernel_launch(void* const* d_in, const int* in_sizes, int n_in, void* d_out, int out_size, void* d_ws, size_t ws_size,
                              hipStream_t stream) {
  static int grid_blocks = 0;
  if (!grid_blocks) {
    int dev = 0, cus = 0, per_cu = 0;
    hipGetDevice(&dev);
    hipDeviceGetAttribute(&cus, hipDeviceAttributeMultiprocessorCount, dev);
    hipFuncSetAttribute((const void*)mega, hipFuncAttributeMaxDynamicSharedMemorySize, SMEM_BYTES);
    hipOccupancyMaxActiveBlocksPerMultiprocessor(&per_cu, mega, 256, SMEM_BYTES);
    if (per_cu > 2) per_cu = 2;
    grid_blocks = cus * per_cu;
  }
  if (ws_size < WS_NEED || n_in < N_IN) { fprintf(stderr, "workspace too small: %zu < %zu\n", ws_size, (size_t)WS_NEED); return; }
  KArgs p{};
  for (int i = 0; i < N_IN; ++i) p.in[i] = (const float*)d_in[i];
  p.out = (float*)d_out;
  p.ws = (char*)d_ws;
  p.ph0 = 0; p.ph1 = N_PHASES;
#ifdef MULTI_LAUNCH
  p.ph0 = -1; p.ph1 = 0;
  hipLaunchKernelGGL(mega, dim3(grid_blocks), dim3(256), SMEM_BYTES, stream, p);
  for (int ph = 0; ph < N_PHASES; ++ph) {
    p.ph0 = ph; p.ph1 = ph + 1;
    hipLaunchKernelGGL(mega, dim3(grid_blocks), dim3(256), SMEM_BYTES, stream, p);
  }
#else
  void* args[] = {&p};
  hipError_t e = hipLaunchCooperativeKernel((void*)mega, dim3(grid_blocks), dim3(256), args, SMEM_BYTES, stream);
  if (e != hipSuccess) fprintf(stderr, "cooperative launch failed: %s (grid %d)\n", hipGetErrorString(e), grid_blocks);
#endif
}
```
